# Optimizing an MI355X kernel written in HIP

```python
import jax, jax.numpy as jnp
from jax import lax
import numpy as np

D_MODEL = 1024
BATCH = 2
SEQ = 8192
DEPTH = 4

N_MIXERS = 2
N_ATTN_LAYERS = (DEPTH + 1) // 2
N_CONV_LAYERS = DEPTH // 2
N_HEADS = 8
QK_NOPE_DIM = 128
QK_ROPE_DIM = 64
QK_HEAD_DIM = QK_NOPE_DIM + QK_ROPE_DIM
V_HEAD_DIM = 128
Q_LORA_RANK = 256
KV_LORA_RANK = 128
DOWN_DIM = Q_LORA_RANK + KV_LORA_RANK + QK_ROPE_DIM
ROPE_THETA = 10000.0
Q_BLOCK = 128
CONV_WIDTH = 3
D_FF = 4 * D_MODEL
EPS = 1e-6
MAX_POS_OFFSET = 1024

kernel_name = 'hybrid_mla_shortconv_sqrelu'


def rms_norm(x, g):
    xf = x.astype(jnp.float32)
    xf = xf * lax.rsqrt(jnp.mean(xf * xf, axis=-1, keepdims=True) + EPS)
    return xf.astype(x.dtype) * g


def rope_tables(positions):
    inv_freq = ROPE_THETA ** (-jnp.arange(0, QK_ROPE_DIM, 2, dtype=jnp.float32) / QK_ROPE_DIM)
    ang = positions.astype(jnp.float32)[..., None] * inv_freq
    return jnp.cos(ang)[:, :, None, :], jnp.sin(ang)[:, :, None, :]


def apply_rope(x, cos, sin):
    x1, x2 = jnp.split(x, 2, axis=-1)
    cos = cos.astype(x.dtype)
    sin = sin.astype(x.dtype)
    return jnp.concatenate([x1 * cos - x2 * sin, x2 * cos + x1 * sin], axis=-1)


def mla_mixer(h, positions, cos, sin, w_down, g_q_a, g_kv_a, w_uq, w_ukv, g_qnorm, g_knorm, w_o):
    b, s, _ = h.shape
    a = h @ w_down
    c_q = rms_norm(a[..., :Q_LORA_RANK], g_q_a)
    c_kv = rms_norm(a[..., Q_LORA_RANK:Q_LORA_RANK + KV_LORA_RANK], g_kv_a)
    k_pe = a[..., Q_LORA_RANK + KV_LORA_RANK:]
    q = (c_q @ w_uq).reshape(b, s, N_HEADS, QK_HEAD_DIM)
    kv = (c_kv @ w_ukv).reshape(b, s, N_HEADS, QK_NOPE_DIM + V_HEAD_DIM)
    k_nope, v = kv[..., :QK_NOPE_DIM], kv[..., QK_NOPE_DIM:]
    k_pe = jnp.broadcast_to(k_pe[:, :, None, :], (b, s, N_HEADS, QK_ROPE_DIM))
    k = jnp.concatenate([k_nope, k_pe], axis=-1)
    q = rms_norm(q, g_qnorm)
    k = rms_norm(k, g_knorm)
    q = jnp.concatenate([q[..., :QK_NOPE_DIM], apply_rope(q[..., QK_NOPE_DIM:], cos, sin)], axis=-1)
    k = jnp.concatenate([k[..., :QK_NOPE_DIM], apply_rope(k[..., QK_NOPE_DIM:], cos, sin)], axis=-1)
    scale = QK_HEAD_DIM ** -0.5
    nb = s // Q_BLOCK
    q_blocks = q.reshape(b, nb, Q_BLOCK, N_HEADS, QK_HEAD_DIM).transpose(1, 0, 2, 3, 4)
    pos_blocks = positions.reshape(b, nb, Q_BLOCK).transpose(1, 0, 2)

    def attend(args):
        q_blk, pos_blk = args
        sc = jnp.einsum('bqhd,bkhd->bhqk', q_blk, k).astype(jnp.float32) * scale
        mask = pos_blk[:, None, :, None] >= positions[:, None, None, :]
        sc = jnp.where(mask, sc, jnp.finfo(jnp.float32).min)
        p = jax.nn.softmax(sc, axis=-1).astype(v.dtype)
        return jnp.einsum('bhqk,bkhd->bqhd', p, v)

    o = lax.map(attend, (q_blocks, pos_blocks))
    o = o.transpose(1, 0, 2, 3, 4).reshape(b, s, N_HEADS * V_HEAD_DIM)
    return o @ w_o


def short_conv_mixer(h, w_in, conv_w, w_out):
    bcu = h @ w_in
    gate_b, gate_c, u = jnp.split(bcu, 3, axis=-1)
    u = gate_c * u
    u = lax.conv_general_dilated(
        u, conv_w[:, None, :], window_strides=(1,), padding=((CONV_WIDTH - 1, 0),),
        dimension_numbers=('NWC', 'WIO', 'NWC'), feature_group_count=D_MODEL)
    return (gate_b * u) @ w_out


def sqrelu_mlp(h, w1, w2):
    return jnp.square(jax.nn.relu(h @ w1)) @ w2


def setup_inputs(seed: int = 0) -> dict:
    key = jax.random.key(seed)
    ks = jax.random.split(key, 20)
    nrm = lambda k, shape, fan_in: jax.random.normal(k, shape, jnp.float32) * fan_in ** -0.5
    gain = lambda k, shape: 1.0 + 0.02 * jax.random.normal(k, shape, jnp.float32)
    x = jax.random.normal(ks[0], (BATCH, SEQ, D_MODEL), jnp.float32)
    offset = jax.random.randint(ks[1], (BATCH, 1), 0, MAX_POS_OFFSET, dtype=jnp.int32)
    positions = offset + jnp.arange(SEQ, dtype=jnp.int32)[None, :]
    return {
        'x': x,
        'positions': positions,
        'g_mix': gain(ks[2], (DEPTH, D_MODEL)),
        'g_mlp': gain(ks[3], (DEPTH, D_MODEL)),
        'attn_w_down': nrm(ks[4], (N_ATTN_LAYERS, D_MODEL, DOWN_DIM), D_MODEL),
        'attn_g_q_a': gain(ks[5], (N_ATTN_LAYERS, Q_LORA_RANK)),
        'attn_g_kv_a': gain(ks[6], (N_ATTN_LAYERS, KV_LORA_RANK)),
        'attn_w_uq': nrm(ks[7], (N_ATTN_LAYERS, Q_LORA_RANK, N_HEADS * QK_HEAD_DIM), Q_LORA_RANK),
        'attn_w_ukv': nrm(ks[8], (N_ATTN_LAYERS, KV_LORA_RANK, N_HEADS * (QK_NOPE_DIM + V_HEAD_DIM)), KV_LORA_RANK),
        'attn_g_qnorm': gain(ks[9], (N_ATTN_LAYERS, QK_HEAD_DIM)),
        'attn_g_knorm': gain(ks[10], (N_ATTN_LAYERS, QK_HEAD_DIM)),
        'attn_w_o': nrm(ks[11], (N_ATTN_LAYERS, N_HEADS * V_HEAD_DIM, D_MODEL), N_HEADS * V_HEAD_DIM),
        'conv_w_in': nrm(ks[12], (N_CONV_LAYERS, D_MODEL, 3 * D_MODEL), D_MODEL),
        'conv_w': nrm(ks[13], (N_CONV_LAYERS, CONV_WIDTH, D_MODEL), CONV_WIDTH),
        'conv_w_out': nrm(ks[14], (N_CONV_LAYERS, D_MODEL, D_MODEL), D_MODEL),
        'mlp_w1': nrm(ks[15], (DEPTH, D_MODEL, D_FF), D_MODEL),
        'mlp_w2': nrm(ks[16], (DEPTH, D_FF, D_MODEL), D_FF),
    }


def reference(x, positions, g_mix, g_mlp, attn_w_down, attn_g_q_a, attn_g_kv_a, attn_w_uq,
              attn_w_ukv, attn_g_qnorm, attn_g_knorm, attn_w_o, conv_w_in, conv_w, conv_w_out,
              mlp_w1, mlp_w2):
    cos, sin = rope_tables(positions)
    for i in range(DEPTH):
        h = rms_norm(x, g_mix[i])
        j = i // N_MIXERS
        if i % N_MIXERS == 0:
            x = x + mla_mixer(h, positions, cos, sin, attn_w_down[j], attn_g_q_a[j], attn_g_kv_a[j],
                              attn_w_uq[j], attn_w_ukv[j], attn_g_qnorm[j], attn_g_knorm[j], attn_w_o[j])
        else:
            x = x + short_conv_mixer(h, conv_w_in[j], conv_w[j], conv_w_out[j])
        h = rms_norm(x, g_mlp[i])
        x = x + sqrelu_mlp(h, mlp_w1[i], mlp_w2[i])
    return x
```

```cpp
#include <hip/hip_runtime.h>
#include <hip/hip_cooperative_groups.h>
#include <cstdio>
#include <cstdint>
namespace cg = cooperative_groups;

#ifndef DBG_MASK
#define DBG_MASK 0xffff
#endif
#define DBG_ON(k) ((DBG_MASK >> (k)) & 1)
#define ATT_NS att2

constexpr int NB = 2, SEQ = 8192, DM = 1024, MT = NB * SEQ, NH = 8, DQK = 192, DNOPE = 128, DROPE = 64, DV = 128;
constexpr int QLORA = 256, KVLORA = 128, DOWN = 448, DOWNP = 512, FF = 4096, NLAYER = 4;
constexpr int QW = NH * DQK;
constexpr float EPS = 1e-6f;
constexpr float QSCALE = 0.07216878364870322f * 1.4426950408889634f;

typedef unsigned short bf16_t;
typedef short bf16x8 __attribute__((ext_vector_type(8)));
typedef float f32x4 __attribute__((ext_vector_type(4)));
typedef float f32x16 __attribute__((ext_vector_type(16)));
typedef unsigned u32x4 __attribute__((ext_vector_type(4)));
typedef unsigned u32x2 __attribute__((ext_vector_type(2)));
#define LAS __attribute__((address_space(3)))

constexpr size_t MiB = 1u << 20;
constexpr size_t WS_CTL = 0;
constexpr size_t WS_SSX = 1 * MiB;
constexpr size_t WS_SSA = 2 * MiB;
constexpr size_t WS_ROPE = 3 * MiB;
constexpr size_t WS_WMIX = 8 * MiB;
constexpr size_t WMLA_BYTES = (size_t)(DOWNP * DM + QW * QLORA + 1024 * KVLORA + 1024 * KVLORA + DM * DM) * 2;
constexpr size_t WCONV_BYTES = (size_t)(3 * DM * DM + DM * DM) * 2;
constexpr size_t WS_WCONV = WS_WMIX + 2 * WMLA_BYTES;
constexpr size_t WS_WMLP = 34 * MiB;
constexpr size_t WS_XA = 52 * MiB, WS_XC = 84 * MiB;
constexpr size_t WS_BIG = 116 * MiB;
constexpr size_t WS_END = 244 * MiB;
static_assert(WS_WCONV + 2 * WCONV_BYTES <= WS_WMLP && WS_WMLP + 16 * MiB <= WS_XA, "ws map");

__device__ __forceinline__ unsigned f2bf(float f) { unsigned u = __builtin_bit_cast(unsigned, f); return (u + 0x7fffu + ((u >> 16) & 1u)) >> 16; }
__device__ __forceinline__ unsigned pk2(float lo, float hi) { return f2bf(lo) | (f2bf(hi) << 16); }
__device__ __forceinline__ float bf2f(bf16_t v) { return __builtin_bit_cast(float, (unsigned)v << 16); }
__device__ __forceinline__ float bflo(unsigned w) { return __builtin_bit_cast(float, w << 16); }
__device__ __forceinline__ float bfhi(unsigned w) { return __builtin_bit_cast(float, w & 0xffff0000u); }
__device__ __forceinline__ float wave_sum(float v) {
#pragma unroll
    for (int o = 1; o < 64; o <<= 1) v += __shfl_xor(v, o);
    return v;
}
__device__ __forceinline__ float wave_max(float v) {
#pragma unroll
    for (int o = 1; o < 64; o <<= 1) v = fmaxf(v, __shfl_xor(v, o));
    return v;
}
__device__ __forceinline__ float rstd_from(const float* ssp, int n4, float inv_dim) {
    float s = 0.f;
    for (int i = 0; i < n4; ++i) { const f32x4 v = ((const f32x4*)ssp)[i]; s += (v.x + v.y) + (v.z + v.w); }
    return rsqrtf(s * inv_dim + EPS);
}

namespace pg8 {
constexpr int BM = 256, BK = 64, HALF = 128, HTB = HALF * BK * 2, STAGE_BYTES = 8 * HTB, NXCD = 8, WGM = 8;
__host__ __device__ __forceinline__ int lds_byte(int r, int c) { const int st = (r >> 4) * 2 + (c >> 5), rr = r & 15, cc = c & 31, ob = rr * 64 + cc * 2; return st * 1024 + (ob ^ (((ob >> 9) & 1) << 5)); }
__host__ __device__ __forceinline__ void stage_rc(int b, int& R, int& C) { const int st = b / 1024, sb = b % 1024, swz = sb ^ (((sb >> 9) & 1) << 5); R = (st >> 1) * 16 + swz / 64; C = (st & 1) * 32 + (swz % 64) / 2; }
__host__ __device__ __forceinline__ int perm32(int rho) { const int n = rho >> 4, i = rho & 15; return 8 * (i >> 2) + 4 * n + (i & 3); }

struct Unit { int pm, pn; };
struct Gemm { const bf16_t* A; const bf16_t* Bt; int M, N, K, lda, ldb; };

struct StaticOrder {
    int nM, nN, nwg, G, c;
    __host__ __device__ void init(int M, int N, int G_, int c_) { nM = M / BM; nN = N / BM; nwg = nM * nN; G = G_; c = c_; }
    __host__ __device__ bool next(int i, Unit& u) const {
        const long L = (long)i * G + c; if (L >= nwg) return false;
        int wgid = (int)L; { const int q = nwg / NXCD, r = nwg % NXCD, xcd = wgid % NXCD, off = wgid / NXCD; wgid = (xcd < r ? xcd * (q + 1) : r * (q + 1) + (xcd - r) * q) + off; }
        const int nig = WGM * nN, gid = wgid / nig, fm = gid * WGM, gsz = (nM - fm) < WGM ? (nM - fm) : WGM;
        u.pm = fm + ((wgid % nig) % gsz); u.pn = (wgid % nig) / gsz; return true;
    }
};

__device__ __forceinline__ unsigned cvt_pk_bf16(float lo, float hi) { unsigned r; asm volatile("v_cvt_pk_bf16_f32 %0, %1, %2" : "=v"(r) : "v"(lo), "v"(hi)); return r; }

template <int ACT  , int REMAP  , int SSMODE> struct EpiScale {
    static constexpr bool PERM = true;
    bf16_t* O; int ldc; const float* ssp; int ss_stride, ss_n4; float inv_dim; float* ss_out;
    const LAS float* tab; int tab_pm;
    __device__ __forceinline__ void operator()(const f32x4 (&acc)[2][2][4][2], const Unit& u, int wr, int wc, int fr, int fq) const {
        const int row0 = u.pm * BM + wr * 64 + fr, colt = u.pn * BM + wc * 32 + 8 * fq;
        float rsv[2][4];
#pragma unroll
        for (int ai = 0; ai < 2; ++ai)
#pragma unroll
            for (int m = 0; m < 4; ++m) rsv[ai][m] = (u.pm == tab_pm) ? tab[wr * 64 + fr + ai * HALF + m * 16] : rstd_from(ssp + (size_t)(row0 + ai * HALF + m * 16) * ss_stride, ss_n4, inv_dim);
#pragma unroll
        for (int ai = 0; ai < 2; ++ai)
#pragma unroll
            for (int m = 0; m < 4; ++m) {
                const int row = row0 + ai * HALF + m * 16;
                const float rs = rsv[ai][m];
                float ssq = 0.f;
#pragma unroll
                for (int bj = 0; bj < 2; ++bj) {
                    const int col = colt + bj * HALF, dcol = REMAP ? ((col >> 7) * 192 + (col & 127)) : col;
                    f32x4 v0 = acc[ai][bj][m][0] * rs, v1 = acc[ai][bj][m][1] * rs;
                    if (SSMODE == 1) { if (u.pn == 0 || bj == 0) ssq += (v0.x * v0.x + v0.y * v0.y) + (v0.z * v0.z + v0.w * v0.w) + (v1.x * v1.x + v1.y * v1.y) + (v1.z * v1.z + v1.w * v1.w); }
                    if (ACT == 1) {
                        v0.x = fmaxf(v0.x, 0.f); v0.y = fmaxf(v0.y, 0.f); v0.z = fmaxf(v0.z, 0.f); v0.w = fmaxf(v0.w, 0.f);
                        v1.x = fmaxf(v1.x, 0.f); v1.y = fmaxf(v1.y, 0.f); v1.z = fmaxf(v1.z, 0.f); v1.w = fmaxf(v1.w, 0.f);
                        v0 = v0 * v0; v1 = v1 * v1; }
                    u32x4 w; w.x = cvt_pk_bf16(v0.x, v0.y); w.y = cvt_pk_bf16(v0.z, v0.w); w.z = cvt_pk_bf16(v1.x, v1.y); w.w = cvt_pk_bf16(v1.z, v1.w);
                    *(u32x4*)(O + (size_t)row * ldc + dcol) = w;
                }
                if (SSMODE == 1) { ssq += __shfl_xor(ssq, 16); ssq += __shfl_xor(ssq, 32); if (fq == 0 && u.pn < 2) ss_out[(size_t)row * 8 + u.pn * 4 + wc] = ssq; }
            }
    }
};
struct EpiConvIn {
    static constexpr bool PERM = true;
    bf16_t* O; const float* ssp; const LAS float* tab; int tab_pm;
    __device__ __forceinline__ void operator()(const f32x4 (&acc)[2][2][4][2], const Unit& u, int wr, int wc, int fr, int fq) const {
        const int row0 = u.pm * BM + wr * 64 + fr, cl = wc * 32 + 8 * fq;
        float rsv[2][4];
#pragma unroll
        for (int ai = 0; ai < 2; ++ai)
#pragma unroll
            for (int m = 0; m < 4; ++m) rsv[ai][m] = (u.pm == tab_pm) ? tab[wr * 64 + fr + ai * HALF + m * 16] : rstd_from(ssp + (size_t)(row0 + ai * HALF + m * 16) * 16, 4, 1.0f / DM);
#pragma unroll
        for (int ai = 0; ai < 2; ++ai)
#pragma unroll
            for (int m = 0; m < 4; ++m) {
                const int row = row0 + ai * HALF + m * 16; const float rs = rsv[ai][m];
                bf16_t* orow = O + (size_t)row * (2 * DM);
                if (u.pn < 4) {
#pragma unroll
                    for (int bj = 0; bj < 2; ++bj) { const f32x4 v0 = acc[ai][bj][m][0] * rs, v1 = acc[ai][bj][m][1] * rs;
                        u32x4 w; w.x = cvt_pk_bf16(v0.x, v0.y); w.y = cvt_pk_bf16(v0.z, v0.w); w.z = cvt_pk_bf16(v1.x, v1.y); w.w = cvt_pk_bf16(v1.z, v1.w);
                        *(u32x4*)(orow + u.pn * BM + bj * HALF + cl) = w; }
                } else {
                    const float r2 = rs * rs;
                    const f32x4 v0 = acc[ai][0][m][0] * acc[ai][1][m][0] * r2, v1 = acc[ai][0][m][1] * acc[ai][1][m][1] * r2;
                    u32x4 w; w.x = cvt_pk_bf16(v0.x, v0.y); w.y = cvt_pk_bf16(v0.z, v0.w); w.z = cvt_pk_bf16(v1.x, v1.y); w.w = cvt_pk_bf16(v1.z, v1.w);
                    *(u32x4*)(orow + DM + (u.pn - 4) * HALF + cl) = w;
                }
            }
    }
};
__device__ __forceinline__ void fill_rstd_tab(LAS float* tab, const float* ssp, int ss_stride, int ss_n4, float inv_dim, int pm, int tid) {
    if (tid < 256) tab[tid] = rstd_from(ssp + (size_t)(pm * BM + tid) * ss_stride, ss_n4, inv_dim);
}
struct EpiVT {
    static constexpr bool PERM = true;
    bf16_t* O; int ldc; const float* ssa;
    __device__ __forceinline__ void operator()(const f32x4 (&acc)[2][2][4][2], const Unit& u, int wr, int wc, int fr, int fq) const {
        const int row0 = u.pm * BM + wr * 64 + fr, colt = u.pn * BM + wc * 32 + 8 * fq;
#pragma unroll
        for (int bj = 0; bj < 2; ++bj) {
            float cs[8];
#pragma unroll
            for (int j = 0; j < 8; ++j) cs[j] = rstd_from(ssa + (size_t)(colt + bj * HALF + j) * 8 + 4, 1, 1.0f / KVLORA);
#pragma unroll
            for (int ai = 0; ai < 2; ++ai)
#pragma unroll
                for (int m = 0; m < 4; ++m) {
                    const int row = row0 + ai * HALF + m * 16;
                    const f32x4 a0 = acc[ai][bj][m][0], a1 = acc[ai][bj][m][1];
                    u32x4 w; w.x = cvt_pk_bf16(a0.x * cs[0], a0.y * cs[1]); w.y = cvt_pk_bf16(a0.z * cs[2], a0.w * cs[3]);
                    w.z = cvt_pk_bf16(a1.x * cs[4], a1.y * cs[5]); w.w = cvt_pk_bf16(a1.z * cs[6], a1.w * cs[7]);
                    *(u32x4*)(O + (size_t)row * ldc + colt + bj * HALF) = w;
                }
            asm volatile("" ::: "memory");
        }
    }
};
template <bool FINAL> struct EpiResid {
    static constexpr bool PERM = true;
    bf16_t* xb; float* xout; float* ssx;
    __device__ __forceinline__ void operator()(const f32x4 (&acc)[2][2][4][2], const Unit& u, int wr, int wc, int fr, int fq) const {
        const int row0 = u.pm * BM + wr * 64 + fr, colt = u.pn * BM + wc * 32 + 8 * fq;
#pragma unroll
        for (int ai = 0; ai < 2; ++ai) {
            u32x4 xv[4][2];
#pragma unroll
            for (int m = 0; m < 4; ++m)
#pragma unroll
                for (int bj = 0; bj < 2; ++bj) xv[m][bj] = *(const u32x4*)(xb + (size_t)(row0 + ai * HALF + m * 16) * DM + colt + bj * HALF);
            asm volatile("" ::: "memory");
#pragma unroll
            for (int m = 0; m < 4; ++m) {
                const int row = row0 + ai * HALF + m * 16; float ssq = 0.f;
#pragma unroll
                for (int bj = 0; bj < 2; ++bj) {
                    const size_t off = (size_t)row * DM + colt + bj * HALF;
                    const u32x4 xw = xv[m][bj];
                    f32x4 v0 = acc[ai][bj][m][0], v1 = acc[ai][bj][m][1];
                    v0.x += bflo(xw.x); v0.y += bfhi(xw.x); v0.z += bflo(xw.y); v0.w += bfhi(xw.y);
                    v1.x += bflo(xw.z); v1.y += bfhi(xw.z); v1.z += bflo(xw.w); v1.w += bfhi(xw.w);
                    if (FINAL) { *(f32x4*)(xout + off) = v0; *(f32x4*)(xout + off + 4) = v1; }
                    else {
                        ssq += (v0.x * v0.x + v0.y * v0.y) + (v0.z * v0.z + v0.w * v0.w) + (v1.x * v1.x + v1.y * v1.y) + (v1.z * v1.z + v1.w * v1.w);
                        u32x4 w; w.x = cvt_pk_bf16(v0.x, v0.y); w.y = cvt_pk_bf16(v0.z, v0.w); w.z = cvt_pk_bf16(v1.x, v1.y); w.w = cvt_pk_bf16(v1.z, v1.w);
                        *(u32x4*)(xb + off) = w;
                    }
                }
                if (!FINAL) { ssq += __shfl_xor(ssq, 16); ssq += __shfl_xor(ssq, 32); if (fq == 0) ssx[(size_t)row * 16 + u.pn * 4 + wc] = ssq; }
            }
            asm volatile("" ::: "memory");
        }
    }
};

template <class Epi, class Sched, bool ALIGN_EPI>
__device__ __forceinline__ void gemm_phase(LAS unsigned char* lds, const Gemm g, const Sched& S, const Epi& E) {
    int tid = threadIdx.x; asm volatile("" : "+v"(tid));
    const int wid = __builtin_amdgcn_readfirstlane(tid >> 6), lane = tid & 63, wr = wid >> 2, wc = wid & 3, fr = lane & 15, fq = lane >> 4;
    int K = g.K; asm volatile("" : "+s"(K));
    const int nt = K / BK;
    unsigned voffA[2], voffB[2];
#pragma unroll
    for (int i = 0; i < 2; ++i) { int R, C; stage_rc(tid * 16 + i * 8192, R, C); const int Rb = Epi::PERM ? ((R & ~31) + perm32(R & 31)) : R;
        voffA[i] = (unsigned)(R * g.lda + C) * 2u; voffB[i] = (unsigned)(Rb * g.ldb + C) * 2u; }
    const size_t kstep = (size_t)(BK * 2);
    const size_t hstepA = (size_t)HALF * g.lda * 2, hstepB = (size_t)HALF * g.ldb * 2;
    const size_t tstepA = 2 * hstepA, tstepB = 2 * hstepB;
    const unsigned ldsw = (unsigned)wid * 1024u;
    const int aoff = lds_byte(wr * 64 + fr, fq * 8), boff = lds_byte(wc * 32 + fr, fq * 8);
#define PG8_SA(b, h) (((b) * 2 + (h)) * HTB)
#define PG8_SB(b, h) ((4 + (b) * 2 + (h)) * HTB)
#define PG8_STAGE(bufoff, gbase, voff) do { _Pragma("unroll") for (int _i = 0; _i < 2; ++_i) \
        __builtin_amdgcn_global_load_lds((const unsigned*)((const char*)(gbase) + (voff)[_i]), (LAS unsigned*)(lds + (bufoff) + ldsw + _i * 8192), 16, 0, 0); } while (0)
#define PG8_LDA(dst, b, h) do { _Pragma("unroll") for (int m = 0; m < 4; ++m) _Pragma("unroll") for (int k = 0; k < 2; ++k) dst[m][k] = *(const LAS bf16x8*)(lds + PG8_SA(b, h) + aoff + m * 2048 + k * 1024); } while (0)
#define PG8_LDB(dst, b, h) do { _Pragma("unroll") for (int n = 0; n < 2; ++n) _Pragma("unroll") for (int k = 0; k < 2; ++k) dst[n][k] = *(const LAS bf16x8*)(lds + PG8_SB(b, h) + boff + n * 2048 + k * 1024); } while (0)
#define PG8_MMA(ai, bj, At, Bt) do { __builtin_amdgcn_s_setprio(1); _Pragma("unroll") for (int m = 0; m < 4; ++m) _Pragma("unroll") for (int n = 0; n < 2; ++n) _Pragma("unroll") for (int k = 0; k < 2; ++k) \
        acc[ai][bj][m][n] = __builtin_amdgcn_mfma_f32_16x16x32_bf16(Bt[n][k], At[m][k], acc[ai][bj][m][n], 0, 0, 0); __builtin_amdgcn_s_setprio(0); } while (0)
#define PG8_WAIT_V(n) asm volatile("s_waitcnt vmcnt(" #n ")" ::: "memory")
#define PG8_WAIT_L(n) asm volatile("s_waitcnt lgkmcnt(" #n ")" ::: "memory")
#define PG8_BAR __builtin_amdgcn_s_barrier()
#define PG8_SCHED __builtin_amdgcn_sched_barrier(0)
    Unit cur, nxt; int ui = 0;
    if (!S.next(0, cur)) return;
    f32x4 acc[2][2][4][2];
#pragma unroll
    for (int a = 0; a < 2; ++a)
#pragma unroll
        for (int b = 0; b < 2; ++b)
#pragma unroll
            for (int m = 0; m < 4; ++m)
#pragma unroll
                for (int n = 0; n < 2; ++n) acc[a][b][m][n] = (f32x4){0.f, 0.f, 0.f, 0.f};
    bf16x8 At[4][2], B0[2][2], B1[2][2];
    const char* cA = (const char*)g.A + (size_t)cur.pm * tstepA; const char* cB = (const char*)g.Bt + (size_t)cur.pn * tstepB;
    PG8_STAGE(PG8_SB(0, 0), cB, voffB); PG8_STAGE(PG8_SB(0, 1), cB + hstepB, voffB); PG8_STAGE(PG8_SA(0, 0), cA, voffA); PG8_STAGE(PG8_SA(0, 1), cA + hstepA, voffA);
    if (wr == 1) PG8_BAR;
    PG8_WAIT_V(2); PG8_BAR;
    PG8_STAGE(PG8_SB(1, 0), cB + kstep, voffB); PG8_STAGE(PG8_SA(1, 0), cA + kstep, voffA); PG8_STAGE(PG8_SB(1, 1), cB + hstepB + kstep, voffB);
    PG8_WAIT_V(6); PG8_BAR;
    for (;;) {
        const bool has_next = S.next(ui + 1, nxt);
        const char* nA = has_next ? (const char*)g.A + (size_t)nxt.pm * tstepA : cA; const char* nB = has_next ? (const char*)g.Bt + (size_t)nxt.pn * tstepB : cB;
        for (int t = 0; t < nt; t += 2) {
            const bool last = (t == nt - 2);
            const char* a1 = cA + (size_t)(t + 1) * kstep;
            const char* a2 = last ? nA : cA + (size_t)(t + 2) * kstep; const char* b2 = last ? nB : cB + (size_t)(t + 2) * kstep;
            const char* a3 = a2 + kstep; const char* b3 = b2 + kstep;
            PG8_LDB(B0, 0, 0); PG8_LDB(B1, 0, 1); PG8_SCHED; PG8_LDA(At, 0, 0); PG8_STAGE(PG8_SA(1, 1), a1 + hstepA, voffA);
            PG8_WAIT_V(8); PG8_WAIT_L(0); PG8_BAR; PG8_MMA(0, 0, At, B0); PG8_MMA(0, 1, At, B1); PG8_BAR; PG8_SCHED;
            PG8_LDA(At, 0, 1); PG8_STAGE(PG8_SB(0, 0), b2, voffB); PG8_STAGE(PG8_SB(0, 1), b2 + hstepB, voffB); PG8_STAGE(PG8_SA(0, 0), a2, voffA);
            PG8_WAIT_V(8); PG8_WAIT_L(0); PG8_BAR; PG8_MMA(1, 0, At, B0); PG8_MMA(1, 1, At, B1); PG8_BAR; PG8_SCHED;
            PG8_LDB(B0, 1, 0); PG8_LDB(B1, 1, 1); PG8_SCHED; PG8_LDA(At, 1, 0); PG8_STAGE(PG8_SA(0, 1), a2 + hstepA, voffA);
            PG8_WAIT_V(8); PG8_WAIT_L(0); PG8_BAR; PG8_MMA(0, 0, At, B0); PG8_MMA(0, 1, At, B1); PG8_BAR; PG8_SCHED;
            PG8_LDA(At, 1, 1); PG8_STAGE(PG8_SB(1, 0), b3, voffB); PG8_STAGE(PG8_SB(1, 1), b3 + hstepB, voffB); PG8_STAGE(PG8_SA(1, 0), a3, voffA);
            PG8_WAIT_V(8); PG8_WAIT_L(0); PG8_BAR; PG8_MMA(1, 0, At, B0); PG8_MMA(1, 1, At, B1); PG8_BAR; PG8_SCHED;
        }
        if constexpr (ALIGN_EPI) { if (wr == 0) PG8_BAR; }
        E(acc, cur, wr, wc, fr, fq);
        if (!has_next) break;
#pragma unroll
        for (int a = 0; a < 2; ++a)
#pragma unroll
            for (int b = 0; b < 2; ++b)
#pragma unroll
                for (int m = 0; m < 4; ++m)
#pragma unroll
                    for (int n = 0; n < 2; ++n) acc[a][b][m][n] = (f32x4){0.f, 0.f, 0.f, 0.f};
        cur = nxt; cA = nA; cB = nB; ++ui;
        if constexpr (ALIGN_EPI) { if (wr == 1) PG8_BAR; }
    }
    PG8_WAIT_V(0);
    if constexpr (!ALIGN_EPI) { if (wr == 0) PG8_BAR; }
    PG8_BAR;
#undef PG8_SA
#undef PG8_SB
#undef PG8_STAGE
#undef PG8_LDA
#undef PG8_LDB
#undef PG8_MMA
#undef PG8_WAIT_V
#undef PG8_WAIT_L
#undef PG8_BAR
#undef PG8_SCHED
}
}

namespace att2 {
constexpr int KBUF = 64 * 384, VBUF = 128 * 128;
constexpr int L_K = 0, L_V = 2 * KBUF, L_WS = L_V + 2 * VBUF, L_END = L_WS + 8 * 128;
constexpr float THR = 8.0f;
typedef float f32x2_t __attribute__((ext_vector_type(2))); typedef __bf16 bf16x2_t __attribute__((ext_vector_type(2)));
__device__ __forceinline__ unsigned cvtpk(float lo, float hi) { f32x2_t v = {lo, hi}; bf16x2_t b = __builtin_convertvector(v, bf16x2_t); return __builtin_bit_cast(unsigned, b); }
__device__ __forceinline__ int kperm(int r) { return (r & ~12) | ((r & 4) << 1) | ((r & 8) >> 1); }
#define SGB(m, n) __builtin_amdgcn_sched_group_barrier(m, n, 0)
__device__ __forceinline__ float rowmax32(const f32x16& a, const f32x16& b) {
    float x = __builtin_fmaxf(__builtin_fmaxf(a[0], a[1]), b[0]), y = __builtin_fmaxf(__builtin_fmaxf(a[2], a[3]), b[1]);
    x = __builtin_fmaxf(__builtin_fmaxf(x, b[2]), b[3]);
#pragma unroll
    for (int r = 4; r < 16; r += 4) { x = __builtin_fmaxf(__builtin_fmaxf(x, a[r]), a[r + 1]); y = __builtin_fmaxf(__builtin_fmaxf(y, a[r + 2]), a[r + 3]);
        x = __builtin_fmaxf(__builtin_fmaxf(x, b[r]), b[r + 1]); y = __builtin_fmaxf(__builtin_fmaxf(y, b[r + 2]), b[r + 3]); }
    return __builtin_fmaxf(x, y);
}
__device__ __forceinline__ float xhalf_max(float m) { auto rr = __builtin_amdgcn_permlane32_swap(__float_as_uint(m), __float_as_uint(m), false, false); return __builtin_fmaxf(__uint_as_float(rr[0]), __uint_as_float(rr[1])); }

__device__ __forceinline__ void attn_unit(LAS unsigned char* lds, int b, int h, int qb, const bf16_t* __restrict__ Q, const bf16_t* __restrict__ Kg, const bf16_t* __restrict__ VT, bf16_t* __restrict__ O, const float* __restrict__ gq, const float* __restrict__ rope) {
    int tid = threadIdx.x; asm volatile("" : "+v"(tid));
    const int lane = tid & 63, r32 = lane & 31, hh = lane >> 5; const int wid = __builtin_amdgcn_readfirstlane(tid >> 6);
    const int q0 = qb * 256, q0w = q0 + wid * 32;
    const size_t tokb = (size_t)b * SEQ;
    const int NT = (q0 + 256) / 64;
    const int my_last = (q0w + 31) / 64;
    unsigned kgo[3], vgo[2];
#pragma unroll
    for (int i = 0; i < 3; ++i) { const int slot = (wid * 3 + i) * 64 + lane, row = slot / 24, cc = slot % 24, c = (cc & ~7) | ((cc & 7) ^ ((row >> 1) & 7)); kgo[i] = (unsigned)(row * QW + c * 8) * 2u; }
#pragma unroll
    for (int i = 0; i < 2; ++i) { const int slot = (wid * 2 + i) * 64 + lane, d = slot >> 3, cc = slot & 7, c = cc ^ ((d >> 1) & 7); vgo[i] = (unsigned)(d * MT + c * 8) * 2u; }
    const char* kbase = (const char*)(Kg + tokb * QW + h * DQK);
    const char* vbase = (const char*)(VT + (size_t)(h * DV) * MT + tokb);
#define A2_DMA_K(t, buf) do { _Pragma("unroll") for (int i = 0; i < 3; ++i) __builtin_amdgcn_global_load_lds((const unsigned*)(kbase + (size_t)(t) * (64 * QW * 2) + kgo[i]), \
        (LAS unsigned*)(lds + L_K + (buf) * KBUF + (wid * 3 + i) * 1024), 16, 0, 0); } while (0)
#define A2_DMA_V(t, buf) do { _Pragma("unroll") for (int i = 0; i < 2; ++i) __builtin_amdgcn_global_load_lds((const unsigned*)(vbase + (size_t)(t) * 128 + vgo[i]), \
        (LAS unsigned*)(lds + L_V + (buf) * VBUF + (wid * 2 + i) * 1024), 16, 0, 0); } while (0)
    A2_DMA_K(0, 0); A2_DMA_V(0, 0); if (NT > 1) A2_DMA_K(1, 1);
    bf16x8 qf[12];
    { const bf16_t* qp = Q + (tokb + q0w + r32) * QW + h * DQK + hh * 8;
#pragma unroll
      for (int st = 0; st < 12; ++st) qf[st] = *(const bf16x8*)(qp + st * 16);
      float ss = 0.f;
#pragma unroll
      for (int st = 0; st < 12; ++st) { const u32x4 w = __builtin_bit_cast(u32x4, qf[st]);
          ss += bflo(w.x) * bflo(w.x) + bfhi(w.x) * bfhi(w.x) + bflo(w.y) * bflo(w.y) + bfhi(w.y) * bfhi(w.y) + bflo(w.z) * bflo(w.z) + bfhi(w.z) * bfhi(w.z) + bflo(w.w) * bflo(w.w) + bfhi(w.w) * bfhi(w.w); }
      { auto rr = __builtin_amdgcn_permlane32_swap(__float_as_uint(ss), __float_as_uint(ss), false, false); ss = __uint_as_float(rr[0]) + __uint_as_float(rr[1]); }
      const float rs = rsqrtf(ss * (1.0f / DQK) + EPS) * QSCALE;
      const float* gp = gq + 8 * hh;
      const float* rp = rope + (tokb + q0w + r32) * 64 + 8 * hh;
#pragma unroll
      for (int st = 0; st < 8; ++st) { const u32x4 w = __builtin_bit_cast(u32x4, qf[st]);
          u32x4 o; o.x = cvtpk(bflo(w.x) * rs, bfhi(w.x) * rs); o.y = cvtpk(bflo(w.y) * rs, bfhi(w.y) * rs);
          o.z = cvtpk(bflo(w.z) * rs, bfhi(w.z) * rs); o.w = cvtpk(bflo(w.w) * rs, bfhi(w.w) * rs);
          qf[st] = __builtin_bit_cast(bf16x8, o); }
#pragma unroll
      for (int st = 8; st < 10; ++st) {
          const u32x4 w1 = __builtin_bit_cast(u32x4, qf[st]), w2 = __builtin_bit_cast(u32x4, qf[st + 2]);
          const f32x4 ga0 = *(const f32x4*)(gp + 16 * st), ga1 = *(const f32x4*)(gp + 16 * st + 4), gb0 = *(const f32x4*)(gp + 16 * st + 32), gb1 = *(const f32x4*)(gp + 16 * st + 36);
          const f32x4 c0 = *(const f32x4*)(rp + 16 * (st - 8)), c1 = *(const f32x4*)(rp + 16 * (st - 8) + 4), s0 = *(const f32x4*)(rp + 32 + 16 * (st - 8)), s1 = *(const f32x4*)(rp + 32 + 16 * (st - 8) + 4);
          float x1[8], x2[8], cs[8], sn[8];
          x1[0] = bflo(w1.x) * rs * ga0.x; x1[1] = bfhi(w1.x) * rs * ga0.y; x1[2] = bflo(w1.y) * rs * ga0.z; x1[3] = bfhi(w1.y) * rs * ga0.w;
          x1[4] = bflo(w1.z) * rs * ga1.x; x1[5] = bfhi(w1.z) * rs * ga1.y; x1[6] = bflo(w1.w) * rs * ga1.z; x1[7] = bfhi(w1.w) * rs * ga1.w;
          x2[0] = bflo(w2.x) * rs * gb0.x; x2[1] = bfhi(w2.x) * rs * gb0.y; x2[2] = bflo(w2.y) * rs * gb0.z; x2[3] = bfhi(w2.y) * rs * gb0.w;
          x2[4] = bflo(w2.z) * rs * gb1.x; x2[5] = bfhi(w2.z) * rs * gb1.y; x2[6] = bflo(w2.w) * rs * gb1.z; x2[7] = bfhi(w2.w) * rs * gb1.w;
          cs[0] = c0.x; cs[1] = c0.y; cs[2] = c0.z; cs[3] = c0.w; cs[4] = c1.x; cs[5] = c1.y; cs[6] = c1.z; cs[7] = c1.w;
          sn[0] = s0.x; sn[1] = s0.y; sn[2] = s0.z; sn[3] = s0.w; sn[4] = s1.x; sn[5] = s1.y; sn[6] = s1.z; sn[7] = s1.w;
          float y1[8], y2[8];
#pragma unroll
          for (int i = 0; i < 8; ++i) { y1[i] = x1[i] * cs[i] - x2[i] * sn[i]; y2[i] = x2[i] * cs[i] + x1[i] * sn[i]; }
          u32x4 o1, o2; o1.x = cvtpk(y1[0], y1[1]); o1.y = cvtpk(y1[2], y1[3]); o1.z = cvtpk(y1[4], y1[5]); o1.w = cvtpk(y1[6], y1[7]);
          o2.x = cvtpk(y2[0], y2[1]); o2.y = cvtpk(y2[2], y2[3]); o2.z = cvtpk(y2[4], y2[5]); o2.w = cvtpk(y2[6], y2[7]);
          qf[st] = __builtin_bit_cast(bf16x8, o1); qf[st + 2] = __builtin_bit_cast(bf16x8, o2); }
    }
    __builtin_amdgcn_sched_barrier(0);
    int ka[4], va[4];
    { const int row = kperm(r32), g = (row >> 1) & 7;
#pragma unroll
      for (int j = 0; j < 4; ++j) ka[j] = L_K + row * 384 + (((2 * j + hh) ^ g) * 16);
      const int gv = (r32 >> 1) & 7;
#pragma unroll
      for (int sI = 0; sI < 4; ++sI) va[sI] = L_V + r32 * 128 + (((2 * sI + hh) ^ gv) * 16); }
#define A2_KF(buf, st, half) (*(const LAS bf16x8*)(lds + ka[(st) & 3] + (buf) * KBUF + ((st) >> 2) * 128 + (half) * (32 * 384)))
#define A2_VF(buf, db, sI) (*(const LAS bf16x8*)(lds + va[sI] + (buf) * VBUF + (db) * (32 * 128)))
    f32x16 o[4];
#pragma unroll
    for (int d = 0; d < 4; ++d)
#pragma unroll
        for (int r = 0; r < 16; ++r) o[d][r] = 0.f;
    float m_run = 0.f, l_run = 0.f;
    f32x16 negm;
#pragma unroll
    for (int r = 0; r < 16; ++r) negm[r] = 0.f;
    LAS float* wsf = (LAS float*)(lds + L_WS + wid * 128);
    asm volatile("s_waitcnt vmcnt(0)" ::: "memory");
    __syncthreads();
    if (wid >= 4) __builtin_amdgcn_s_setprio(1);
    f32x16 s0, s1;
    { s0 = negm; s1 = negm;
#pragma unroll
      for (int st = 0; st < 12; ++st) { s0 = __builtin_amdgcn_mfma_f32_32x32x16_bf16(A2_KF(0, st, 0), qf[st], s0, 0, 0, 0); s1 = __builtin_amdgcn_mfma_f32_32x32x16_bf16(A2_KF(0, st, 1), qf[st], s1, 0, 0, 0); }
      if (63 > q0w) { const int qi = q0w + r32, kv0 = 8 * hh;
#pragma unroll
          for (int r = 0; r < 16; ++r) { const int kv = kv0 + (r & 7) + 16 * (r >> 3); if (kv > qi) s0[r] = -1e30f; if (kv + 32 > qi) s1[r] = -1e30f; } }
      const float rm = xhalf_max(rowmax32(s0, s1));
      m_run = rm;
#pragma unroll
      for (int r = 0; r < 16; ++r) { s0[r] -= rm; s1[r] -= rm; negm[r] = -rm; }
    }
    asm volatile("s_waitcnt lgkmcnt(0)" ::: "memory");
    __builtin_amdgcn_s_barrier();
    asm volatile("" ::: "memory");
    for (int t = 0; t < NT; ++t) {
        const int cb = t & 1, nb = cb ^ 1;
        if (t + 2 < NT) A2_DMA_K(t + 2, cb);
        if (t + 1 < NT) A2_DMA_V(t + 1, nb);
        if (t <= my_last) {
            const bool has_next = (t + 1 <= my_last);
            f32x16 n0 = negm, n1 = negm;
            bf16x8 pf[4];
            float ls = 0.f;
            if (has_next) {
#pragma unroll
                for (int st = 0; st < 12; ++st) { n0 = __builtin_amdgcn_mfma_f32_32x32x16_bf16(A2_KF(nb, st, 0), qf[st], n0, 0, 0, 0); n1 = __builtin_amdgcn_mfma_f32_32x32x16_bf16(A2_KF(nb, st, 1), qf[st], n1, 0, 0, 0); }
            }
#pragma unroll
            for (int r = 0; r < 16; ++r) { s0[r] = __builtin_amdgcn_exp2f(s0[r]); s1[r] = __builtin_amdgcn_exp2f(s1[r]); }
#pragma unroll
            for (int r = 0; r < 16; ++r) ls += s0[r] + s1[r];
#pragma unroll
            for (int sI = 0; sI < 4; ++sI) { u32x4 w;
                if (sI < 2) { w.x = cvtpk(s0[8 * sI + 0], s0[8 * sI + 1]); w.y = cvtpk(s0[8 * sI + 2], s0[8 * sI + 3]); w.z = cvtpk(s0[8 * sI + 4], s0[8 * sI + 5]); w.w = cvtpk(s0[8 * sI + 6], s0[8 * sI + 7]); }
                else { const int s2 = sI - 2; w.x = cvtpk(s1[8 * s2 + 0], s1[8 * s2 + 1]); w.y = cvtpk(s1[8 * s2 + 2], s1[8 * s2 + 3]); w.z = cvtpk(s1[8 * s2 + 4], s1[8 * s2 + 5]); w.w = cvtpk(s1[8 * s2 + 6], s1[8 * s2 + 7]); }
                pf[sI] = __builtin_bit_cast(bf16x8, w); }
            l_run += ls;
            if (has_next) {
                SGB(0x100, 4);
#pragma unroll
                for (int i = 0; i < 20; ++i) { SGB(0x008, 1); SGB(0x100, 1); SGB(0x002, 4); }
#pragma unroll
                for (int i = 0; i < 4; ++i) { SGB(0x008, 1); SGB(0x002, 4); }
                __builtin_amdgcn_sched_barrier(0);
                if ((t + 1) * 64 + 63 > q0w) { const int qi = q0w + r32, kv0 = (t + 1) * 64 + 8 * hh;
#pragma unroll
                    for (int r = 0; r < 16; ++r) { const int kv = kv0 + (r & 7) + 16 * (r >> 3); if (kv > qi) n0[r] = -1e30f; if (kv + 32 > qi) n1[r] = -1e30f; } }
                __builtin_amdgcn_sched_barrier(0);
            }
#pragma unroll
            for (int sI = 0; sI < 4; ++sI)
#pragma unroll
                for (int d = 0; d < 4; ++d) o[d] = __builtin_amdgcn_mfma_f32_32x32x16_bf16(pf[sI], A2_VF(cb, d, sI), o[d], 0, 0, 0);
            float rm = -1e30f;
            if (has_next) rm = xhalf_max(rowmax32(n0, n1));
            SGB(0x100, 4);
#pragma unroll
            for (int i = 0; i < 12; ++i) { SGB(0x008, 1); SGB(0x100, 1); SGB(0x002, 2); }
#pragma unroll
            for (int i = 0; i < 4; ++i) { SGB(0x008, 1); SGB(0x002, 2); }
            __builtin_amdgcn_sched_barrier(0);
            if (__any(rm > THR)) {
                const float dl = __builtin_fmaxf(rm, 0.f), al = __builtin_amdgcn_exp2f(-dl);
                m_run += dl; l_run *= al;
#pragma unroll
                for (int r = 0; r < 16; ++r) { n0[r] -= dl; n1[r] -= dl; negm[r] = -m_run; }
                if (hh == 0) wsf[r32] = al;
                asm volatile("s_waitcnt lgkmcnt(0)" ::: "memory");
#pragma unroll
                for (int g = 0; g < 4; ++g) { const f32x4 a4 = *(const LAS f32x4*)(wsf + 8 * g + 4 * hh);
#pragma unroll
                    for (int d = 0; d < 4; ++d) { o[d][4 * g + 0] *= a4.x; o[d][4 * g + 1] *= a4.y; o[d][4 * g + 2] *= a4.z; o[d][4 * g + 3] *= a4.w; } }
                asm volatile("s_waitcnt lgkmcnt(0)" ::: "memory");
            }
            s0 = n0; s1 = n1;
        }
        asm volatile("s_waitcnt vmcnt(0) lgkmcnt(0)" ::: "memory");
        __builtin_amdgcn_s_barrier();
        asm volatile("" ::: "memory");
    }
    __builtin_amdgcn_s_setprio(0);
    l_run += __shfl_xor(l_run, 32);
    if (hh == 0) wsf[r32] = 1.0f / l_run;
    asm volatile("s_waitcnt lgkmcnt(0)" ::: "memory");
    LAS bf16_t* stg = (LAS bf16_t*)(lds + wid * 8192);
#pragma unroll
    for (int g = 0; g < 4; ++g) { const f32x4 a4 = *(const LAS f32x4*)(wsf + 8 * g + 4 * hh);
#pragma unroll
        for (int i = 0; i < 4; ++i) { const int row = 8 * g + 4 * hh + i; const float sc = (i == 0) ? a4.x : (i == 1) ? a4.y : (i == 2) ? a4.z : a4.w;
#pragma unroll
            for (int d = 0; d < 4; ++d) stg[row * 128 + d * 32 + r32] = (bf16_t)f2bf(o[d][4 * g + i] * sc); } }
    asm volatile("s_waitcnt lgkmcnt(0)" ::: "memory");
    { bf16_t* ob = O + (tokb + q0w) * DM + h * DV;
#pragma unroll
      for (int k = 0; k < 8; ++k) { const int chunk = k * 64 + lane, row = chunk >> 4, c16 = chunk & 15;
          const u32x4 v = *(const LAS u32x4*)(stg + row * 128 + c16 * 8); *(u32x4*)(ob + (size_t)row * DM + c16 * 8) = v; } }
    asm volatile("s_waitcnt lgkmcnt(0)" ::: "memory");
    __builtin_amdgcn_s_barrier();
    asm volatile("" ::: "memory");
#undef A2_DMA_K
#undef A2_DMA_V
#undef A2_KF
#undef A2_VF
}
__device__ __forceinline__ void attn_phase(LAS unsigned char* lds, int vcu, int G, const bf16_t* Q, const bf16_t* Kg, const bf16_t* VT, bf16_t* O, const float* gq, const float* rope) {
    for (int p = vcu; p < 256; p += G) {
        const int bh = p >> 4, s = p & 15;
        attn_unit(lds, bh >> 3, bh & 7, 31 - s, Q, Kg, VT, O, gq, rope);
        attn_unit(lds, bh >> 3, bh & 7, s, Q, Kg, VT, O, gq, rope);
    }
}
#undef SGB
}

__device__ __forceinline__ void transpose_item(const float* __restrict__ W, int N, int k0, int n0, bf16_t* dst, int ldk, const float* __restrict__ gain, LAS float* scr, int lane) {
    f32x4 v[8]; float gv[8];
#pragma unroll
    for (int i = 0; i < 8; ++i) { const int kk = 8 * i + (lane >> 3); v[i] = *(const f32x4*)(W + (size_t)(k0 + kk) * N + n0 + (lane & 7) * 4); gv[i] = gain ? gain[k0 + kk] : 1.0f; }
#pragma unroll
    for (int i = 0; i < 8; ++i) { const int kk = 8 * i + (lane >> 3); LAS float* p = scr + kk * 33 + (lane & 7) * 4; p[0] = v[i].x * gv[i]; p[1] = v[i].y * gv[i]; p[2] = v[i].z * gv[i]; p[3] = v[i].w * gv[i]; }
    asm volatile("s_waitcnt lgkmcnt(0)" ::: "memory");
    const int c = lane & 7;
#pragma unroll
    for (int j = 0; j < 4; ++j) { const int n = (lane >> 3) + 8 * j; const LAS float* s = scr + (8 * c) * 33 + n;
        u32x4 o; o.x = pk2(s[0 * 33], s[1 * 33]); o.y = pk2(s[2 * 33], s[3 * 33]); o.z = pk2(s[4 * 33], s[5 * 33]); o.w = pk2(s[6 * 33], s[7 * 33]);
        *(u32x4*)(dst + (size_t)n * ldk + k0 + 8 * c) = o; }
    asm volatile("s_waitcnt lgkmcnt(0)" ::: "memory");
}
struct In {
    const float* x; const int* pos; const float *g_mix, *g_mlp, *w_down, *g_q_a, *g_kv_a, *w_uq, *w_ukv, *g_qn, *g_kn, *w_o, *c_w_in, *c_w, *c_w_out, *w1, *w2;
};
struct MlaW { bf16_t *wd, *wuq, *wuk, *wuvt, *wo; };
struct ConvW { bf16_t *win, *wout; };
__device__ __forceinline__ MlaW mla_w(unsigned char* ws, int j) { MlaW w; bf16_t* p = (bf16_t*)(ws + WS_WMIX + (size_t)j * WMLA_BYTES);
    w.wd = p; p += DOWNP * DM; w.wuq = p; p += QW * QLORA; w.wuk = p; p += 1024 * KVLORA; w.wuvt = p; p += 1024 * KVLORA; w.wo = p; return w; }
__device__ __forceinline__ ConvW conv_w(unsigned char* ws, int j) { ConvW w; bf16_t* p = (bf16_t*)(ws + WS_WCONV + (size_t)j * WCONV_BYTES); w.win = p; w.wout = p + 3 * DM * DM; return w; }

__device__ __forceinline__ void convert_mlp(const In& in, unsigned char* ws, int L, LAS float* scr, int gw, int NGW, int lane) {
    bf16_t* w1t = (bf16_t*)(ws + WS_WMLP); bf16_t* w2t = w1t + (size_t)FF * DM;
    const float* w1 = in.w1 + (size_t)L * DM * FF; const float* w2 = in.w2 + (size_t)L * FF * DM; const float* g = in.g_mlp + L * DM;
    constexpr int I1 = (DM / 64) * (FF / 32), I2 = (FF / 64) * (DM / 32);
    for (int it = gw; it < I1 + I2; it += NGW) {
        if (it < I1) { const int kb = it / (FF / 32), nb = it % (FF / 32); transpose_item(w1, FF, kb * 64, nb * 32, w1t + (size_t)(nb * 32) * DM, DM, g, scr, lane); }
        else { const int r = it - I1, kb = r / (DM / 32), nb = r % (DM / 32); transpose_item(w2, DM, kb * 64, nb * 32, w2t + (size_t)(nb * 32) * FF, FF, nullptr, scr, lane); }
    }
}
__device__ __forceinline__ void convert_conv(const In& in, unsigned char* ws, int j, LAS float* scr, int gw, int NGW, int lane) {
    constexpr int I_IN = (DM / 64) * (3 * DM / 32), I_OUT = (DM / 64) * (DM / 32);
    const ConvW w = conv_w(ws, j);
    for (int r = gw; r < I_IN + I_OUT; r += NGW) {
        if (r < I_IN) { const int kb = r / (3 * DM / 32), nb = r % (3 * DM / 32), n0 = nb * 32;
            const int part = n0 >> 10, ch0 = n0 & 1023, drow = (part == 0) ? n0 : (1024 + (ch0 >> 7) * 256 + (part - 1) * 128 + (ch0 & 127));
            transpose_item(in.c_w_in + (size_t)j * DM * 3 * DM, 3 * DM, kb * 64, n0, w.win + (size_t)drow * DM, DM, in.g_mix + (2 * j + 1) * DM, scr, lane); }
        else { const int q = r - I_IN, kb = q / (DM / 32), nb = q % (DM / 32); transpose_item(in.c_w_out + (size_t)j * DM * DM, DM, kb * 64, nb * 32, w.wout + (size_t)(nb * 32) * DM, DM, nullptr, scr, lane); }
    }
}
__device__ __forceinline__ void prologue(const In& in, unsigned char* ws, LAS unsigned char* lds, int vcu, int G, int tid) {
    const int lane = tid & 63, wave = tid >> 6, gw = vcu * 8 + wave, NGW = G * 8;
    LAS float* scr = (LAS float*)(lds + wave * 16384);
    constexpr int I_D = (DM / 64) * (DOWN / 32), I_Q = (QLORA / 64) * (QW / 32), I_KV = (KVLORA / 64) * (2048 / 32), I_O = (DM / 64) * (DM / 32);
    constexpr int I_MLA = I_D + I_Q + I_KV + I_O;
    constexpr int I_IN = (DM / 64) * (3 * DM / 32), I_OUT = I_O, I_CONV = I_IN + I_OUT;
    for (int it = gw; it < 2 * I_MLA; it += NGW) {
        const int j = it / I_MLA; int r = it % I_MLA; const MlaW w = mla_w(ws, j);
        if (r < I_D) { const int kb = r / (DOWN / 32), nb = r % (DOWN / 32); transpose_item(in.w_down + (size_t)j * DM * DOWN, DOWN, kb * 64, nb * 32, w.wd + (size_t)(nb * 32) * DM, DM, in.g_mix + (2 * j) * DM, scr, lane); continue; } r -= I_D;
        if (r < I_Q) { const int kb = r / (QW / 32), nb = r % (QW / 32); transpose_item(in.w_uq + (size_t)j * QLORA * QW, QW, kb * 64, nb * 32, w.wuq + (size_t)(nb * 32) * QLORA, QLORA, in.g_q_a + j * QLORA, scr, lane); continue; } r -= I_Q;
        if (r < I_KV) { const int kb = r / 64, nb = r % 64, n0 = nb * 32, hd = n0 >> 8, j0 = n0 & 255;
            bf16_t* dst = (j0 < 128) ? (w.wuk + (size_t)(hd * 128 + j0) * KVLORA) : (w.wuvt + (size_t)(hd * 128 + j0 - 128) * KVLORA);
            transpose_item(in.w_ukv + (size_t)j * KVLORA * 2048, 2048, kb * 64, n0, dst, KVLORA, in.g_kv_a + j * KVLORA, scr, lane); continue; } r -= I_KV;
        { const int kb = r / (DM / 32), nb = r % (DM / 32); transpose_item(in.w_o + (size_t)j * DM * DM, DM, kb * 64, nb * 32, w.wo + (size_t)(nb * 32) * DM, DM, nullptr, scr, lane); }
    }
    { const int gt = vcu * 512 + tid, NT = G * 512;
      for (int i = gt; i < 2 * (DOWNP - DOWN) * DM / 8; i += NT) { const int j = i / ((DOWNP - DOWN) * DM / 8), r = i % ((DOWNP - DOWN) * DM / 8);
          *(u32x4*)(mla_w(ws, j).wd + (size_t)DOWN * DM + (size_t)r * 8) = (u32x4){0u, 0u, 0u, 0u}; }
      float* rope = (float*)(ws + WS_ROPE);
      for (int i = gt; i < MT * 32; i += NT) { const int tok = i >> 5, f = i & 31;
          const float inv = (float)exp2(-(double)f * (13.287712379549449 / 32.0));
          const float ang = (float)in.pos[tok] * inv;
          float sn_, cs_; sincosf(ang, &sn_, &cs_);
          rope[(size_t)tok * 64 + f] = cs_; rope[(size_t)tok * 64 + 32 + f] = sn_; }
    }
    bf16_t* xb = (bf16_t*)(ws + WS_XA); float* ssx = (float*)(ws + WS_SSX);
    for (int m = gw; m < MT; m += 2 * NGW) {
        const int m2 = m + NGW; const bool has2 = m2 < MT;
        const f32x4* xr = (const f32x4*)(in.x + (size_t)m * DM) + lane; const f32x4* xr2 = (const f32x4*)(in.x + (size_t)(has2 ? m2 : m) * DM) + lane;
        f32x4 va[4], vb[4];
#pragma unroll
        for (int j = 0; j < 4; ++j) { va[j] = xr[64 * j]; vb[j] = xr2[64 * j]; }
        float s = 0.f, s2 = 0.f;
        unsigned long long* o8 = (unsigned long long*)(xb + (size_t)m * DM) + lane; unsigned long long* o82 = (unsigned long long*)(xb + (size_t)m2 * DM) + lane;
#pragma unroll
        for (int j = 0; j < 4; ++j) { const f32x4 v = va[j]; s += (v.x * v.x + v.y * v.y) + (v.z * v.z + v.w * v.w);
            o8[64 * j] = (unsigned long long)pk2(v.x, v.y) | ((unsigned long long)pk2(v.z, v.w) << 32); }
        if (has2) {
#pragma unroll
            for (int j = 0; j < 4; ++j) { const f32x4 v = vb[j]; s2 += (v.x * v.x + v.y * v.y) + (v.z * v.z + v.w * v.w);
                o82[64 * j] = (unsigned long long)pk2(v.x, v.y) | ((unsigned long long)pk2(v.z, v.w) << 32); }
        }
        s = wave_sum(s); s2 = wave_sum(s2);
        if (lane < 16) { ssx[(size_t)m * 16 + lane] = (lane == 0) ? s : 0.f; if (has2) ssx[(size_t)m2 * 16 + lane] = (lane == 0) ? s2 : 0.f; }
    }
}
__device__ __forceinline__ void qk_head24(u32x4& c0, u32x4& c1, u32x4& c2, const float (&g)[24], const float (&cs)[8], const float (&sn)[8], int s, float osc) {
    float e[24];
    e[0] = bflo(c0.x); e[1] = bfhi(c0.x); e[2] = bflo(c0.y); e[3] = bfhi(c0.y); e[4] = bflo(c0.z); e[5] = bfhi(c0.z); e[6] = bflo(c0.w); e[7] = bfhi(c0.w);
    e[8] = bflo(c1.x); e[9] = bfhi(c1.x); e[10] = bflo(c1.y); e[11] = bfhi(c1.y); e[12] = bflo(c1.z); e[13] = bfhi(c1.z); e[14] = bflo(c1.w); e[15] = bfhi(c1.w);
    e[16] = bflo(c2.x); e[17] = bfhi(c2.x); e[18] = bflo(c2.y); e[19] = bfhi(c2.y); e[20] = bflo(c2.z); e[21] = bfhi(c2.z); e[22] = bflo(c2.w); e[23] = bfhi(c2.w);
    float ss = 0.f;
#pragma unroll
    for (int i = 0; i < 24; ++i) ss += e[i] * e[i];
    ss += __shfl_xor(ss, 1); ss += __shfl_xor(ss, 2); ss += __shfl_xor(ss, 4);
    const float rs = rsqrtf(ss * (1.0f / DQK) + EPS);
#pragma unroll
    for (int i = 0; i < 24; ++i) e[i] = e[i] * rs * g[i];
#pragma unroll
    for (int i = 0; i < 8; ++i) { const float pr = __shfl_xor(e[16 + i], 4); e[16 + i] = (s < 4) ? (e[16 + i] * cs[i] - pr * sn[i]) : (e[16 + i] * cs[i] + pr * sn[i]); }
#pragma unroll
    for (int i = 0; i < 24; ++i) e[i] *= osc;
    c0.x = pk2(e[0], e[1]); c0.y = pk2(e[2], e[3]); c0.z = pk2(e[4], e[5]); c0.w = pk2(e[6], e[7]);
    c1.x = pk2(e[8], e[9]); c1.y = pk2(e[10], e[11]); c1.z = pk2(e[12], e[13]); c1.w = pk2(e[14], e[15]);
    c2.x = pk2(e[16], e[17]); c2.y = pk2(e[18], e[19]); c2.z = pk2(e[20], e[21]); c2.w = pk2(e[22], e[23]);
}
__device__ __forceinline__ void knorm_unit(const float* __restrict__ gk, const float* __restrict__ gq, const float* __restrict__ rope, bf16_t* kb, const bf16_t* __restrict__ a, int pm, int pn, int tid) {
    const int lane = tid & 63, wave = tid >> 6, slot = lane >> 3, s = lane & 7;
    float gkv[24];
#pragma unroll
    for (int c = 0; c < 3; ++c)
#pragma unroll
        for (int i = 0; i < 8; ++i) gkv[8 * c + i] = gk[64 * c + 8 * s + i] * (c < 2 ? gq[64 * c + 8 * s + i] : 1.0f);
#pragma unroll 1
    for (int bt = 0; bt < 2; ++bt) {
        u32x4 k0[4], k1[4], k2[4]; f32x4 rc[4][2], rsn[4][2];
#pragma unroll
        for (int q4 = 0; q4 < 4; ++q4) { const int it = bt * 4 + q4, tok = pm * 256 + wave * 32 + it * 4 + (slot >> 1), hd = 2 * pn + (slot & 1);
            const bf16_t* kr = kb + (size_t)tok * QW + hd * DQK + 8 * s;
            k0[q4] = *(const u32x4*)(kr); k1[q4] = *(const u32x4*)(kr + 64); k2[q4] = *(const u32x4*)(a + (size_t)tok * DOWNP + 384 + 8 * s);
            rc[q4][0] = *(const f32x4*)(rope + (size_t)tok * 64 + 8 * (s & 3)); rc[q4][1] = *(const f32x4*)(rope + (size_t)tok * 64 + 8 * (s & 3) + 4);
            rsn[q4][0] = *(const f32x4*)(rope + (size_t)tok * 64 + 32 + 8 * (s & 3)); rsn[q4][1] = *(const f32x4*)(rope + (size_t)tok * 64 + 32 + 8 * (s & 3) + 4); }
        asm volatile("" ::: "memory");
#pragma unroll
        for (int q4 = 0; q4 < 4; ++q4) { const int it = bt * 4 + q4, tok = pm * 256 + wave * 32 + it * 4 + (slot >> 1), hd = 2 * pn + (slot & 1);
            bf16_t* kr = kb + (size_t)tok * QW + hd * DQK + 8 * s;
            float cs[8], sn[8];
            cs[0] = rc[q4][0].x; cs[1] = rc[q4][0].y; cs[2] = rc[q4][0].z; cs[3] = rc[q4][0].w; cs[4] = rc[q4][1].x; cs[5] = rc[q4][1].y; cs[6] = rc[q4][1].z; cs[7] = rc[q4][1].w;
            sn[0] = rsn[q4][0].x; sn[1] = rsn[q4][0].y; sn[2] = rsn[q4][0].z; sn[3] = rsn[q4][0].w; sn[4] = rsn[q4][1].x; sn[5] = rsn[q4][1].y; sn[6] = rsn[q4][1].z; sn[7] = rsn[q4][1].w;
            qk_head24(k0[q4], k1[q4], k2[q4], gkv, cs, sn, s, 1.0f);
            *(u32x4*)(kr) = k0[q4]; *(u32x4*)(kr + 64) = k1[q4]; *(u32x4*)(kr + 128) = k2[q4]; }
        asm volatile("" ::: "memory");
    }
}
__device__ __forceinline__ void conv_gate(const float* __restrict__ cw  , const bf16_t* __restrict__ bcu, bf16_t* __restrict__ y, int vcu, int G, int tid) {
    constexpr int CHUNK = 16, LD = 2 * DM;
    const int gt = vcu * 512 + tid, NT = G * 512;
    for (int i = gt; i < (MT / CHUNK) * (DM / 8); i += NT) {
        const int c8 = (i & 127) * 8, tok0 = (i >> 7) * CHUNK, t0 = tok0 & (SEQ - 1);
        float w[3][8];
#pragma unroll
        for (int k = 0; k < 3; ++k) { const f32x4 a0 = *(const f32x4*)(cw + k * DM + c8), a1 = *(const f32x4*)(cw + k * DM + c8 + 4);
            w[k][0] = a0.x; w[k][1] = a0.y; w[k][2] = a0.z; w[k][3] = a0.w; w[k][4] = a1.x; w[k][5] = a1.y; w[k][6] = a1.z; w[k][7] = a1.w; }
        float p1[8], p2[8];
#pragma unroll
        for (int e = 0; e < 8; ++e) { p1[e] = 0.f; p2[e] = 0.f; }
        if (t0 > 0) {
            const u32x4 u2 = *(const u32x4*)(bcu + (size_t)(tok0 - 2) * LD + DM + c8), u1 = *(const u32x4*)(bcu + (size_t)(tok0 - 1) * LD + DM + c8);
            p2[0] = bflo(u2.x); p2[1] = bfhi(u2.x); p2[2] = bflo(u2.y); p2[3] = bfhi(u2.y); p2[4] = bflo(u2.z); p2[5] = bfhi(u2.z); p2[6] = bflo(u2.w); p2[7] = bfhi(u2.w);
            p1[0] = bflo(u1.x); p1[1] = bfhi(u1.x); p1[2] = bflo(u1.y); p1[3] = bfhi(u1.y); p1[4] = bflo(u1.z); p1[5] = bfhi(u1.z); p1[6] = bflo(u1.w); p1[7] = bfhi(u1.w);
        }
#pragma unroll 4
        for (int k = 0; k < CHUNK; ++k) {
            const bf16_t* row = bcu + (size_t)(tok0 + k) * LD;
            const u32x4 gb = *(const u32x4*)(row + c8), uc = *(const u32x4*)(row + DM + c8);
            float p0[8], gbf[8];
            p0[0] = bflo(uc.x); p0[1] = bfhi(uc.x); p0[2] = bflo(uc.y); p0[3] = bfhi(uc.y); p0[4] = bflo(uc.z); p0[5] = bfhi(uc.z); p0[6] = bflo(uc.w); p0[7] = bfhi(uc.w);
            gbf[0] = bflo(gb.x); gbf[1] = bfhi(gb.x); gbf[2] = bflo(gb.y); gbf[3] = bfhi(gb.y); gbf[4] = bflo(gb.z); gbf[5] = bfhi(gb.z); gbf[6] = bflo(gb.w); gbf[7] = bfhi(gb.w);
            float o[8];
#pragma unroll
            for (int e = 0; e < 8; ++e) { o[e] = gbf[e] * (w[0][e] * p2[e] + w[1][e] * p1[e] + w[2][e] * p0[e]); p2[e] = p1[e]; p1[e] = p0[e]; }
            u32x4 ov; ov.x = pk2(o[0], o[1]); ov.y = pk2(o[2], o[3]); ov.z = pk2(o[4], o[5]); ov.w = pk2(o[6], o[7]);
            *(u32x4*)(y + (size_t)(tok0 + k) * DM + c8) = ov;
        }
    }
}

#define XB_TMO      128
#define XB_XCNT(j)  (256  + 64 * (j))
#define XB_XSUB(j)  (1280 + 64 * (j))
#define XB_XGEN(j)  (2304 + 64 * (j))
#define XB_TOP      3328
#define XB_TOPGEN   3392
#define XCD_BAR_WORDS 3456
#define XB_SPIN_CAP (1u << 18)
__device__ __forceinline__ unsigned xb_ld(unsigned* p)              { return __hip_atomic_load(p, __ATOMIC_RELAXED, __HIP_MEMORY_SCOPE_AGENT); }
__device__ __forceinline__ unsigned xb_add(unsigned* p, unsigned v) { return __hip_atomic_fetch_add(p, v, __ATOMIC_RELAXED, __HIP_MEMORY_SCOPE_AGENT); }
__device__ __forceinline__ unsigned xb_xcc_id() { return (unsigned)__builtin_amdgcn_s_getreg((3 << 11) | 20) & 0xFu; }
#define XB_SPIN(cond, bar) do { unsigned _sp = 0; while (cond) { __builtin_amdgcn_s_sleep(1); \
    if ((++_sp & 255u) == 0u) { if (xb_ld(&(bar)[XB_TMO])) break; if (_sp > XB_SPIN_CAP) { atomicAdd(&(bar)[XB_TMO], 1u); break; } } } } while (0)
struct XcdBarrier { unsigned* bar; unsigned x; volatile LAS unsigned* st; };
__device__ __forceinline__ XcdBarrier xcd_barrier_post(unsigned* bar, volatile LAS unsigned* st) {
    XcdBarrier b; b.bar = bar; b.x = xb_xcc_id(); b.st = st;
    if (threadIdx.x == 0) (void)xb_add(&bar[XB_XCNT(b.x)], 1u);
    return b;
}
__device__ __forceinline__ void xcd_barrier_complete(unsigned* bar, unsigned x, unsigned& nloc, unsigned& nx) {
    const unsigned G = gridDim.x * gridDim.y * gridDim.z;
    unsigned sum, cnt, mine, sp = 0u;
    for (;;) {
        sum = 0u; cnt = 0u; mine = 0u;
#pragma unroll
        for (unsigned j = 0; j < 16; ++j) { const unsigned c = xb_ld(&bar[XB_XCNT(j)]); sum += c; cnt += (c > 0u) ? 1u : 0u; mine = (j == x) ? c : mine; }
        if (sum == G) break;
        __builtin_amdgcn_s_sleep(1);
        if ((++sp & 255u) == 0u) { if (xb_ld(&bar[XB_TMO])) break; if (sp > XB_SPIN_CAP) { atomicAdd(&bar[XB_TMO], 1u); break; } }
    }
    nloc = mine > 0u ? mine : 1u; nx = cnt > 0u ? cnt : 1u;
}
__device__ __forceinline__ void xcd_barrier(const XcdBarrier& b) {
    asm volatile("s_waitcnt vmcnt(0)" ::: "memory");
    __syncthreads();
    if (threadIdx.x == 0) {
        unsigned* bar = b.bar;
        __builtin_amdgcn_s_waitcnt(0);
        unsigned nloc = b.st[0], nx = b.st[1];
        if (nloc == 0u) { xcd_barrier_complete(bar, b.x, nloc, nx); b.st[0] = nloc; b.st[1] = nx; }
        const unsigned old = xb_add(&bar[XB_XSUB(b.x)], 1u);
        const unsigned gen = old / nloc;
        if (old + 1u == (gen + 1u) * nloc) {
            __builtin_amdgcn_fence(__ATOMIC_RELEASE, "agent");
            asm volatile("s_waitcnt vmcnt(0)" ::: "memory");
            const unsigned og = xb_add(&bar[XB_TOP], 1u);
            const unsigned tg = og / nx;
            if (og + 1u == (tg + 1u) * nx) xb_add(&bar[XB_TOPGEN], 1u);
            else XB_SPIN(xb_ld(&bar[XB_TOPGEN]) == tg, bar);
            __builtin_amdgcn_fence(__ATOMIC_ACQUIRE, "agent");
            xb_add(&bar[XB_XGEN(b.x)], 1u);
            asm volatile("s_waitcnt vmcnt(0)" ::: "memory");
        } else {
            XB_SPIN(xb_ld(&bar[XB_XGEN(b.x)]) == gen, bar);
            __builtin_amdgcn_fence(__ATOMIC_ACQUIRE, "agent");
            asm volatile("s_waitcnt vmcnt(0)" ::: "memory");
        }
    }
    __syncthreads();
}

constexpr int RING_BYTES = 131072, MISC_OFF = RING_BYTES + 320, LDS_BYTES = 147456;
static_assert(att2::L_END <= RING_BYTES && pg8::STAGE_BYTES <= RING_BYTES, "LDS map");
constexpr int PH_PER_LAYER = 7, NPH = 1 + NLAYER * PH_PER_LAYER;
struct Args { In in; float* out; unsigned char* ws; int ph_lo, ph_hi, nogemm, noattn; };

__global__ void __launch_bounds__(512, 2) mk_fwd(Args args) {
    extern __shared__ __attribute__((aligned(16))) unsigned char lds_raw[];
    LAS unsigned char* lds = (LAS unsigned char*)lds_raw;
    const int tid = threadIdx.x, G = gridDim.x, bx = blockIdx.x;
    const int vcu = (G % 8 == 0) ? (bx % 8) * (G / 8) + bx / 8 : bx;
    unsigned char* ws = args.ws; const In& in = args.in;
    const int lo = args.ph_lo, hi = args.ph_hi;
    cg::grid_group grid = cg::this_grid();
    volatile LAS unsigned* MISC = (volatile LAS unsigned*)(lds + MISC_OFF);
    if (tid < 32) MISC[tid] = 0u;
    __syncthreads();
#define GRID_BAR() xcd_barrier(bar)
#define IN(k) (lo <= (k) && (k) < hi)
#define SEAM(k) do { if (IN(k) && IN((k) + 1)) GRID_BAR(); } while (0)

    if (bx == 0) { unsigned* bw = (unsigned*)(ws + WS_CTL) + 1024; for (int i = tid; i < XCD_BAR_WORDS; i += 512) bw[i] = 0u; }
    prologue(in, ws, lds, vcu, G, tid);
    grid.sync();
    XcdBarrier bar = xcd_barrier_post((unsigned*)(ws + WS_CTL) + 1024, MISC + 8);
    bf16_t* cur = (bf16_t*)(ws + WS_XA); bf16_t* alt = (bf16_t*)(ws + WS_XC);
    bf16_t* big = (bf16_t*)(ws + WS_BIG);
    float* ssx = (float*)(ws + WS_SSX); float* ssa = (float*)(ws + WS_SSA);
    bf16_t* w1t = (bf16_t*)(ws + WS_WMLP); bf16_t* w2t = w1t + (size_t)FF * DM;
    for (int L = 0; L < NLAYER; ++L) {
        const int base = 1 + L * PH_PER_LAYER, j = L >> 1; const bool mla = !(L & 1);
        int tl = tid; asm volatile("" : "+v"(tl));
        if (IN(base + 0)) {
            constexpr int NU_DOWN = (MT / 256) * (DOWNP / 256);
            { const bool idle_only = mla && G > NU_DOWN && !args.nogemm;
              const int cgw = (idle_only ? (bx - NU_DOWN) : vcu) * 8 + (tl >> 6), cngw = (idle_only ? (G - NU_DOWN) : G) * 8;
              if (!idle_only || bx >= NU_DOWN) {
                  convert_mlp(in, ws, L, (LAS float*)(lds + (tl >> 6) * 16384), cgw, cngw, tl & 63);
                  if (mla) convert_conv(in, ws, j, (LAS float*)(lds + (tl >> 6) * 16384), cgw, cngw, tl & 63);
              } }
            __syncthreads();
            if (!args.nogemm) {
                if (mla) {
                    pg8::Gemm g{cur, mla_w(ws, j).wd, MT, DOWNP, DM, DM, DM}; pg8::StaticOrder S; S.init(MT, DOWNP, G, bx);
                    int tpm = -1; { pg8::Unit u0; if (S.next(0, u0)) { tpm = u0.pm; pg8::fill_rstd_tab((LAS float*)(lds + RING_BYTES + 1024), ssx, 16, 4, 1.0f / DM, tpm, tl); } } __syncthreads();
                    pg8::EpiScale<0, 0, 1> E{alt, DOWNP, ssx, 16, 4, 1.0f / DM, ssa, (LAS float*)(lds + RING_BYTES + 1024), tpm};
                    if (DBG_ON(0)) pg8::gemm_phase<pg8::EpiScale<0, 0, 1>, pg8::StaticOrder, true>(lds, g, S, E);
                } else {
                    pg8::Gemm g{cur, conv_w(ws, j).win, MT, 3 * DM, DM, DM, DM}; pg8::StaticOrder S; S.init(MT, 3 * DM, G, bx);
                    int tpm = -1; { pg8::Unit u0; if (S.next(0, u0)) { tpm = u0.pm; pg8::fill_rstd_tab((LAS float*)(lds + RING_BYTES + 1024), ssx, 16, 4, 1.0f / DM, tpm, tl); } } __syncthreads();
                    pg8::EpiConvIn E{big, ssx, (LAS float*)(lds + RING_BYTES + 1024), tpm};
                    if (DBG_ON(1)) pg8::gemm_phase<pg8::EpiConvIn, pg8::StaticOrder, true>(lds, g, S, E);
                }
            }
        }
        if (mla) {
            bf16_t* qb = big; bf16_t* kb = big + (size_t)MT * QW; bf16_t* vt = kb + (size_t)MT * QW;
            SEAM(base + 0);
            if (IN(base + 1) && !args.nogemm) {
                const MlaW w = mla_w(ws, j);
                { pg8::Gemm g{alt, w.wuq, MT, QW, QLORA, DOWNP, QLORA}; pg8::StaticOrder S; S.init(MT, QW, G, bx);
                  pg8::EpiScale<0, 0, 0> E{qb, QW, ssa, 8, 1, 1.0f / QLORA, nullptr, nullptr, -1};
                  if (DBG_ON(2)) pg8::gemm_phase<pg8::EpiScale<0, 0, 0>, pg8::StaticOrder, true>(lds, g, S, E); }
                { pg8::Gemm g{alt + QLORA, w.wuk, MT, 1024, KVLORA, DOWNP, KVLORA}; pg8::StaticOrder S; S.init(MT, 1024, G, bx);
                  pg8::EpiScale<0, 1, 0> E{kb, QW, ssa + 4, 8, 1, 1.0f / KVLORA, nullptr, nullptr, -1};
                  if (DBG_ON(3)) pg8::gemm_phase<pg8::EpiScale<0, 1, 0>, pg8::StaticOrder, true>(lds, g, S, E);
                  if ((tl >> 6) == 0) __builtin_amdgcn_fence(__ATOMIC_ACQUIRE, "agent");
                  asm volatile("s_waitcnt vmcnt(0)" ::: "memory"); __syncthreads();
                  pg8::Unit u; for (int i = 0; S.next(i, u); ++i) knorm_unit(in.g_kn + j * DQK, in.g_qn + j * DQK, (const float*)(ws + WS_ROPE), kb, alt, u.pm, u.pn, tl); }
                { pg8::Gemm g{w.wuvt, alt + QLORA, 1024, MT, KVLORA, KVLORA, DOWNP}; pg8::StaticOrder S; S.init(1024, MT, G, bx);
                  pg8::EpiVT E{vt, MT, ssa};
                  if (DBG_ON(4)) pg8::gemm_phase<pg8::EpiVT, pg8::StaticOrder, true>(lds, g, S, E); }
            }
            SEAM(base + 1);
                        if (IN(base + 3) && !args.noattn) ATT_NS::attn_phase(lds, vcu, G, qb, kb, vt, alt, in.g_qn + j * DQK, (const float*)(ws + WS_ROPE));
            SEAM(base + 3);
            if (IN(base + 4) && !args.nogemm) {
                pg8::Gemm g{alt, mla_w(ws, j).wo, MT, DM, DM, DM, DM}; pg8::StaticOrder S; S.init(MT, DM, G, bx);
                pg8::EpiResid<false> E{cur, nullptr, ssx};
                if (DBG_ON(5)) pg8::gemm_phase<pg8::EpiResid<false>, pg8::StaticOrder, true>(lds, g, S, E);
            }
            SEAM(base + 4);
        } else {
            SEAM(base + 0);
            if (IN(base + 2)) conv_gate(in.c_w + (size_t)j * 3 * DM, big, alt, vcu, G, tl);
            if (IN(base + 2) && IN(base + 4)) GRID_BAR();
            if (IN(base + 4) && !args.nogemm) {
                pg8::Gemm g{alt, conv_w(ws, j).wout, MT, DM, DM, DM, DM}; pg8::StaticOrder S; S.init(MT, DM, G, bx);
                pg8::EpiResid<false> E{cur, nullptr, ssx};
                if (DBG_ON(6)) pg8::gemm_phase<pg8::EpiResid<false>, pg8::StaticOrder, true>(lds, g, S, E);
            }
            SEAM(base + 4);
        }
        if (IN(base + 5) && !args.nogemm) {
            pg8::Gemm g{cur, w1t, MT, FF, DM, DM, DM}; pg8::StaticOrder S; S.init(MT, FF, G, bx);
            int tpm = -1; { pg8::Unit u0; if (S.next(0, u0)) { tpm = u0.pm; pg8::fill_rstd_tab((LAS float*)(lds + RING_BYTES + 1024), ssx, 16, 4, 1.0f / DM, tpm, tl); } } __syncthreads();
            pg8::EpiScale<1, 0, 0> E{big, FF, ssx, 16, 4, 1.0f / DM, nullptr, (LAS float*)(lds + RING_BYTES + 1024), tpm};
            if (DBG_ON(7)) pg8::gemm_phase<pg8::EpiScale<1, 0, 0>, pg8::StaticOrder, true>(lds, g, S, E);
        }
        SEAM(base + 5);
        if (IN(base + 6) && !args.nogemm) {
            pg8::Gemm g{big, w2t, MT, DM, FF, FF, FF}; pg8::StaticOrder S; S.init(MT, DM, G, bx);
            if (L + 1 < NLAYER) { pg8::EpiResid<false> E{cur, nullptr, ssx};
                if (DBG_ON(8)) pg8::gemm_phase<pg8::EpiResid<false>, pg8::StaticOrder, true>(lds, g, S, E); }
            else { pg8::EpiResid<true> E{cur, args.out, ssx};
                if (DBG_ON(8)) pg8::gemm_phase<pg8::EpiResid<true>, pg8::StaticOrder, true>(lds, g, S, E); }
        }
        if (L + 1 < NLAYER) SEAM(base + 6);
    }
#undef IN
#undef SEAM
}

extern "C" void kernel_launch(void* const* d_in, const int* in_sizes, int n_in, void* d_out, int out_size, void* d_ws, size_t ws_size, hipStream_t stream) {
    static int grid = 0;
    if (grid == 0) {
        if (n_in != 17 || out_size != MT * DM || ws_size < WS_END) { fprintf(stderr, "kernel_launch: unexpected problem shape (n_in %d, out %d, ws %zu)\n", n_in, out_size, ws_size); grid = -1; return; }
        int dev = 0, cus = 0, per_cu = 0;
        hipGetDevice(&dev); hipDeviceGetAttribute(&cus, hipDeviceAttributeMultiprocessorCount, dev);
        if (hipFuncSetAttribute((const void*)mk_fwd, hipFuncAttributeMaxDynamicSharedMemorySize, LDS_BYTES) != hipSuccess) { fprintf(stderr, "kernel_launch: hipFuncSetAttribute failed\n"); grid = -1; return; }
        if (hipOccupancyMaxActiveBlocksPerMultiprocessor(&per_cu, (const void*)mk_fwd, 512, LDS_BYTES) != hipSuccess || per_cu < 1) { fprintf(stderr, "kernel_launch: occupancy query says %d\n", per_cu); per_cu = 1; }
        (void)hipGetLastError();
        grid = cus * per_cu;
    }
    if (grid < 0) return;
    Args a{};
    const void** ip = (const void**)&a.in;
    for (int i = 0; i < 17; ++i) ip[i] = d_in[i];
    a.out = (float*)d_out; a.ws = (unsigned char*)d_ws; a.nogemm = 0; a.noattn = 0;
    a.ph_lo = 0; a.ph_hi = NPH;
    void* kargs[] = {&a};
    hipError_t e = hipLaunchCooperativeKernel((const void*)mk_fwd, dim3(grid), dim3(512), kargs, LDS_BYTES, stream);
    if (e != hipSuccess) fprintf(stderr, "kernel_launch: cooperative launch failed: %s (grid %d)\n", hipGetErrorString(e), grid);
}
```

```cpp
#include <hip/hip_runtime.h>
#include <hip/hip_cooperative_groups.h>
#include <cstdio>
#include <cstdint>
namespace cg = cooperative_groups;

#ifndef DBG_MASK
#define DBG_MASK 0xffff
#endif
#define DBG_ON(k) ((DBG_MASK >> (k)) & 1)
#define ATT_NS att2

constexpr int NB = 2, SEQ = 8192, DM = 1024, MT = NB * SEQ, NH = 8, DQK = 192, DNOPE = 128, DROPE = 64, DV = 128;
constexpr int QLORA = 256, KVLORA = 128, DOWN = 448, DOWNP = 512, FF = 4096, NLAYER = 4;
constexpr int QW = NH * DQK;
constexpr float EPS = 1e-6f;
constexpr float QSCALE = 0.07216878364870322f * 1.4426950408889634f;

typedef unsigned short bf16_t;
typedef short bf16x8 __attribute__((ext_vector_type(8)));
typedef float f32x4 __attribute__((ext_vector_type(4)));
typedef float f32x16 __attribute__((ext_vector_type(16)));
typedef unsigned u32x4 __attribute__((ext_vector_type(4)));
typedef unsigned u32x2 __attribute__((ext_vector_type(2)));
#define LAS __attribute__((address_space(3)))

constexpr size_t MiB = 1u << 20;
constexpr size_t WS_CTL = 0;
constexpr size_t WS_SSX = 1 * MiB;
constexpr size_t WS_SSA = 2 * MiB;
constexpr size_t WS_ROPE = 3 * MiB;
constexpr size_t WS_WMIX = 8 * MiB;
constexpr size_t WMLA_BYTES = (size_t)(DOWNP * DM + QW * QLORA + 1024 * KVLORA + 1024 * KVLORA + DM * DM) * 2;
constexpr size_t WCONV_BYTES = (size_t)(3 * DM * DM + DM * DM) * 2;
constexpr size_t WS_WCONV = WS_WMIX + 2 * WMLA_BYTES;
constexpr size_t WS_WMLP = 34 * MiB;
constexpr size_t WS_XA = 52 * MiB, WS_XC = 84 * MiB;
constexpr size_t WS_BIG = 116 * MiB;
constexpr size_t WS_END = 244 * MiB;
static_assert(WS_WCONV + 2 * WCONV_BYTES <= WS_WMLP && WS_WMLP + 16 * MiB <= WS_XA, "ws map");

__device__ __forceinline__ unsigned f2bf(float f) { unsigned u = __builtin_bit_cast(unsigned, f); return (u + 0x7fffu + ((u >> 16) & 1u)) >> 16; }
__device__ __forceinline__ unsigned pk2(float lo, float hi) { return f2bf(lo) | (f2bf(hi) << 16); }
__device__ __forceinline__ float bf2f(bf16_t v) { return __builtin_bit_cast(float, (unsigned)v << 16); }
__device__ __forceinline__ float bflo(unsigned w) { return __builtin_bit_cast(float, w << 16); }
__device__ __forceinline__ float bfhi(unsigned w) { return __builtin_bit_cast(float, w & 0xffff0000u); }
__device__ __forceinline__ float wave_sum(float v) {
#pragma unroll
    for (int o = 1; o < 64; o <<= 1) v += __shfl_xor(v, o);
    return v;
}
__device__ __forceinline__ float wave_max(float v) {
#pragma unroll
    for (int o = 1; o < 64; o <<= 1) v = fmaxf(v, __shfl_xor(v, o));
    return v;
}
__device__ __forceinline__ float rstd_from(const float* ssp, int n4, float inv_dim) {
    float s = 0.f;
    for (int i = 0; i < n4; ++i) { const f32x4 v = ((const f32x4*)ssp)[i]; s += (v.x + v.y) + (v.z + v.w); }
    return rsqrtf(s * inv_dim + EPS);
}

namespace pg8 {
constexpr int BM = 256, BK = 64, HALF = 128, HTB = HALF * BK * 2, STAGE_BYTES = 8 * HTB, NXCD = 8, WGM = 8;
__host__ __device__ __forceinline__ int lds_byte(int r, int c) { const int st = (r >> 4) * 2 + (c >> 5), rr = r & 15, cc = c & 31, ob = rr * 64 + cc * 2; return st * 1024 + (ob ^ (((ob >> 9) & 1) << 5)); }
__host__ __device__ __forceinline__ void stage_rc(int b, int& R, int& C) { const int st = b / 1024, sb = b % 1024, swz = sb ^ (((sb >> 9) & 1) << 5); R = (st >> 1) * 16 + swz / 64; C = (st & 1) * 32 + (swz % 64) / 2; }
__host__ __device__ __forceinline__ int perm32(int rho) { const int n = rho >> 4, i = rho & 15; return 8 * (i >> 2) + 4 * n + (i & 3); }

struct Unit { int pm, pn; };
struct Gemm { const bf16_t* A; const bf16_t* Bt; int M, N, K, lda, ldb; };

struct StaticOrder {
    int nM, nN, nwg, G, c;
    __host__ __device__ void init(int M, int N, int G_, int c_) { nM = M / BM; nN = N / BM; nwg = nM * nN; G = G_; c = c_; }
    __host__ __device__ bool next(int i, Unit& u) const {
        const long L = (long)i * G + c; if (L >= nwg) return false;
        int wgid = (int)L; { const int q = nwg / NXCD, r = nwg % NXCD, xcd = wgid % NXCD, off = wgid / NXCD; wgid = (xcd < r ? xcd * (q + 1) : r * (q + 1) + (xcd - r) * q) + off; }
        const int nig = WGM * nN, gid = wgid / nig, fm = gid * WGM, gsz = (nM - fm) < WGM ? (nM - fm) : WGM;
        u.pm = fm + ((wgid % nig) % gsz); u.pn = (wgid % nig) / gsz; return true;
    }
};

__device__ __forceinline__ unsigned cvt_pk_bf16(float lo, float hi) { unsigned r; asm volatile("v_cvt_pk_bf16_f32 %0, %1, %2" : "=v"(r) : "v"(lo), "v"(hi)); return r; }

template <int ACT  , int REMAP  , int SSMODE> struct EpiScale {
    static constexpr bool PERM = true;
    bf16_t* O; int ldc; const float* ssp; int ss_stride, ss_n4; float inv_dim; float* ss_out;
    const LAS float* tab; int tab_pm;
    __device__ __forceinline__ void operator()(const f32x4 (&acc)[2][2][4][2], const Unit& u, int wr, int wc, int fr, int fq) const {
        const int row0 = u.pm * BM + wr * 64 + fr, colt = u.pn * BM + wc * 32 + 8 * fq;
        float rsv[2][4];
#pragma unroll
        for (int ai = 0; ai < 2; ++ai)
#pragma unroll
            for (int m = 0; m < 4; ++m) rsv[ai][m] = (u.pm == tab_pm) ? tab[wr * 64 + fr + ai * HALF + m * 16] : rstd_from(ssp + (size_t)(row0 + ai * HALF + m * 16) * ss_stride, ss_n4, inv_dim);
#pragma unroll
        for (int ai = 0; ai < 2; ++ai)
#pragma unroll
            for (int m = 0; m < 4; ++m) {
                const int row = row0 + ai * HALF + m * 16;
                const float rs = rsv[ai][m];
                float ssq = 0.f;
#pragma unroll
                for (int bj = 0; bj < 2; ++bj) {
                    const int col = colt + bj * HALF, dcol = REMAP ? ((col >> 7) * 192 + (col & 127)) : col;
                    f32x4 v0 = acc[ai][bj][m][0] * rs, v1 = acc[ai][bj][m][1] * rs;
                    if (SSMODE == 1) { if (u.pn == 0 || bj == 0) ssq += (v0.x * v0.x + v0.y * v0.y) + (v0.z * v0.z + v0.w * v0.w) + (v1.x * v1.x + v1.y * v1.y) + (v1.z * v1.z + v1.w * v1.w); }
                    if (ACT == 1) {
                        v0.x = fmaxf(v0.x, 0.f); v0.y = fmaxf(v0.y, 0.f); v0.z = fmaxf(v0.z, 0.f); v0.w = fmaxf(v0.w, 0.f);
                        v1.x = fmaxf(v1.x, 0.f); v1.y = fmaxf(v1.y, 0.f); v1.z = fmaxf(v1.z, 0.f); v1.w = fmaxf(v1.w, 0.f);
                        v0 = v0 * v0; v1 = v1 * v1; }
                    u32x4 w; w.x = cvt_pk_bf16(v0.x, v0.y); w.y = cvt_pk_bf16(v0.z, v0.w); w.z = cvt_pk_bf16(v1.x, v1.y); w.w = cvt_pk_bf16(v1.z, v1.w);
                    *(u32x4*)(O + (size_t)row * ldc + dcol) = w;
                }
                if (SSMODE == 1) { ssq += __shfl_xor(ssq, 16); ssq += __shfl_xor(ssq, 32); if (fq == 0 && u.pn < 2) ss_out[(size_t)row * 8 + u.pn * 4 + wc] = ssq; }
            }
    }
};
struct EpiConvIn {
    static constexpr bool PERM = true;
    bf16_t* O; const float* ssp; const LAS float* tab; int tab_pm;
    __device__ __forceinline__ void operator()(const f32x4 (&acc)[2][2][4][2], const Unit& u, int wr, int wc, int fr, int fq) const {
        const int row0 = u.pm * BM + wr * 64 + fr, cl = wc * 32 + 8 * fq;
        float rsv[2][4];
#pragma unroll
        for (int ai = 0; ai < 2; ++ai)
#pragma unroll
            for (int m = 0; m < 4; ++m) rsv[ai][m] = (u.pm == tab_pm) ? tab[wr * 64 + fr + ai * HALF + m * 16] : rstd_from(ssp + (size_t)(row0 + ai * HALF + m * 16) * 16, 4, 1.0f / DM);
#pragma unroll
        for (int ai = 0; ai < 2; ++ai)
#pragma unroll
            for (int m = 0; m < 4; ++m) {
                const int row = row0 + ai * HALF + m * 16; const float rs = rsv[ai][m];
                bf16_t* orow = O + (size_t)row * (2 * DM);
                if (u.pn < 4) {
#pragma unroll
                    for (int bj = 0; bj < 2; ++bj) { const f32x4 v0 = acc[ai][bj][m][0] * rs, v1 = acc[ai][bj][m][1] * rs;
                        u32x4 w; w.x = cvt_pk_bf16(v0.x, v0.y); w.y = cvt_pk_bf16(v0.z, v0.w); w.z = cvt_pk_bf16(v1.x, v1.y); w.w = cvt_pk_bf16(v1.z, v1.w);
                        *(u32x4*)(orow + u.pn * BM + bj * HALF + cl) = w; }
                } else {
                    const float r2 = rs * rs;
                    const f32x4 v0 = acc[ai][0][m][0] * acc[ai][1][m][0] * r2, v1 = acc[ai][0][m][1] * acc[ai][1][m][1] * r2;
                    u32x4 w; w.x = cvt_pk_bf16(v0.x, v0.y); w.y = cvt_pk_bf16(v0.z, v0.w); w.z = cvt_pk_bf16(v1.x, v1.y); w.w = cvt_pk_bf16(v1.z, v1.w);
                    *(u32x4*)(orow + DM + (u.pn - 4) * HALF + cl) = w;
                }
            }
    }
};
__device__ __forceinline__ void fill_rstd_tab(LAS float* tab, const float* ssp, int ss_stride, int ss_n4, float inv_dim, int pm, int tid) {
    if (tid < 256) tab[tid] = rstd_from(ssp + (size_t)(pm * BM + tid) * ss_stride, ss_n4, inv_dim);
}
struct EpiVT {
    static constexpr bool PERM = true;
    bf16_t* O; int ldc; const float* ssa;
    __device__ __forceinline__ void operator()(const f32x4 (&acc)[2][2][4][2], const Unit& u, int wr, int wc, int fr, int fq) const {
        const int row0 = u.pm * BM + wr * 64 + fr, colt = u.pn * BM + wc * 32 + 8 * fq;
#pragma unroll
        for (int bj = 0; bj < 2; ++bj) {
            float cs[8];
#pragma unroll
            for (int j = 0; j < 8; ++j) cs[j] = rstd_from(ssa + (size_t)(colt + bj * HALF + j) * 8 + 4, 1, 1.0f / KVLORA);
#pragma unroll
            for (int ai = 0; ai < 2; ++ai)
#pragma unroll
                for (int m = 0; m < 4; ++m) {
                    const int row = row0 + ai * HALF + m * 16;
                    const f32x4 a0 = acc[ai][bj][m][0], a1 = acc[ai][bj][m][1];
                    u32x4 w; w.x = cvt_pk_bf16(a0.x * cs[0], a0.y * cs[1]); w.y = cvt_pk_bf16(a0.z * cs[2], a0.w * cs[3]);
                    w.z = cvt_pk_bf16(a1.x * cs[4], a1.y * cs[5]); w.w = cvt_pk_bf16(a1.z * cs[6], a1.w * cs[7]);
                    *(u32x4*)(O + (size_t)row * ldc + colt + bj * HALF) = w;
                }
            asm volatile("" ::: "memory");
        }
    }
};
template <bool FINAL> struct EpiResid {
    static constexpr bool PERM = true;
    bf16_t* xb; float* xout; float* ssx;
    __device__ __forceinline__ void operator()(const f32x4 (&acc)[2][2][4][2], const Unit& u, int wr, int wc, int fr, int fq) const {
        const int row0 = u.pm * BM + wr * 64 + fr, colt = u.pn * BM + wc * 32 + 8 * fq;
#pragma unroll
        for (int ai = 0; ai < 2; ++ai) {
            u32x4 xv[4][2];
#pragma unroll
            for (int m = 0; m < 4; ++m)
#pragma unroll
                for (int bj = 0; bj < 2; ++bj) xv[m][bj] = *(const u32x4*)(xb + (size_t)(row0 + ai * HALF + m * 16) * DM + colt + bj * HALF);
            asm volatile("" ::: "memory");
#pragma unroll
            for (int m = 0; m < 4; ++m) {
                const int row = row0 + ai * HALF + m * 16; float ssq = 0.f;
#pragma unroll
                for (int bj = 0; bj < 2; ++bj) {
                    const size_t off = (size_t)row * DM + colt + bj * HALF;
                    const u32x4 xw = xv[m][bj];
                    f32x4 v0 = acc[ai][bj][m][0], v1 = acc[ai][bj][m][1];
                    v0.x += bflo(xw.x); v0.y += bfhi(xw.x); v0.z += bflo(xw.y); v0.w += bfhi(xw.y);
                    v1.x += bflo(xw.z); v1.y += bfhi(xw.z); v1.z += bflo(xw.w); v1.w += bfhi(xw.w);
                    if (FINAL) { *(f32x4*)(xout + off) = v0; *(f32x4*)(xout + off + 4) = v1; }
                    else {
                        ssq += (v0.x * v0.x + v0.y * v0.y) + (v0.z * v0.z + v0.w * v0.w) + (v1.x * v1.x + v1.y * v1.y) + (v1.z * v1.z + v1.w * v1.w);
                        u32x4 w; w.x = cvt_pk_bf16(v0.x, v0.y); w.y = cvt_pk_bf16(v0.z, v0.w); w.z = cvt_pk_bf16(v1.x, v1.y); w.w = cvt_pk_bf16(v1.z, v1.w);
                        *(u32x4*)(xb + off) = w;
                    }
                }
                if (!FINAL) { ssq += __shfl_xor(ssq, 16); ssq += __shfl_xor(ssq, 32); if (fq == 0) ssx[(size_t)row * 16 + u.pn * 4 + wc] = ssq; }
            }
            asm volatile("" ::: "memory");
        }
    }
};

template <class Epi, class Sched, bool ALIGN_EPI>
__device__ __forceinline__ void gemm_phase(LAS unsigned char* lds, const Gemm g, const Sched& S, const Epi& E) {
    int tid = threadIdx.x; asm volatile("" : "+v"(tid));
    const int wid = __builtin_amdgcn_readfirstlane(tid >> 6), lane = tid & 63, wr = wid >> 2, wc = wid & 3, fr = lane & 15, fq = lane >> 4;
    int K = g.K; asm volatile("" : "+s"(K));
    const int nt = K / BK;
    unsigned voffA[2], voffB[2];
#pragma unroll
    for (int i = 0; i < 2; ++i) { int R, C; stage_rc(tid * 16 + i * 8192, R, C); const int Rb = Epi::PERM ? ((R & ~31) + perm32(R & 31)) : R;
        voffA[i] = (unsigned)(R * g.lda + C) * 2u; voffB[i] = (unsigned)(Rb * g.ldb + C) * 2u; }
    const size_t kstep = (size_t)(BK * 2);
    const size_t hstepA = (size_t)HALF * g.lda * 2, hstepB = (size_t)HALF * g.ldb * 2;
    const size_t tstepA = 2 * hstepA, tstepB = 2 * hstepB;
    const unsigned ldsw = (unsigned)wid * 1024u;
    const int aoff = lds_byte(wr * 64 + fr, fq * 8), boff = lds_byte(wc * 32 + fr, fq * 8);
#define PG8_SA(b, h) (((b) * 2 + (h)) * HTB)
#define PG8_SB(b, h) ((4 + (b) * 2 + (h)) * HTB)
#define PG8_STAGE(bufoff, gbase, voff) do { _Pragma("unroll") for (int _i = 0; _i < 2; ++_i) \
        __builtin_amdgcn_global_load_lds((const unsigned*)((const char*)(gbase) + (voff)[_i]), (LAS unsigned*)(lds + (bufoff) + ldsw + _i * 8192), 16, 0, 0); } while (0)
#define PG8_LDA(dst, b, h) do { _Pragma("unroll") for (int m = 0; m < 4; ++m) _Pragma("unroll") for (int k = 0; k < 2; ++k) dst[m][k] = *(const LAS bf16x8*)(lds + PG8_SA(b, h) + aoff + m * 2048 + k * 1024); } while (0)
#define PG8_LDB(dst, b, h) do { _Pragma("unroll") for (int n = 0; n < 2; ++n) _Pragma("unroll") for (int k = 0; k < 2; ++k) dst[n][k] = *(const LAS bf16x8*)(lds + PG8_SB(b, h) + boff + n * 2048 + k * 1024); } while (0)
#define PG8_MMA(ai, bj, At, Bt) do { __builtin_amdgcn_s_setprio(1); _Pragma("unroll") for (int m = 0; m < 4; ++m) _Pragma("unroll") for (int n = 0; n < 2; ++n) _Pragma("unroll") for (int k = 0; k < 2; ++k) \
        acc[ai][bj][m][n] = __builtin_amdgcn_mfma_f32_16x16x32_bf16(Bt[n][k], At[m][k], acc[ai][bj][m][n], 0, 0, 0); __builtin_amdgcn_s_setprio(0); } while (0)
#define PG8_WAIT_V(n) asm volatile("s_waitcnt vmcnt(" #n ")" ::: "memory")
#define PG8_WAIT_L(n) asm volatile("s_waitcnt lgkmcnt(" #n ")" ::: "memory")
#define PG8_BAR __builtin_amdgcn_s_barrier()
#define PG8_SCHED __builtin_amdgcn_sched_barrier(0)
    Unit cur, nxt; int ui = 0;
    if (!S.next(0, cur)) return;
    f32x4 acc[2][2][4][2];
#pragma unroll
    for (int a = 0; a < 2; ++a)
#pragma unroll
        for (int b = 0; b < 2; ++b)
#pragma unroll
            for (int m = 0; m < 4; ++m)
#pragma unroll
                for (int n = 0; n < 2; ++n) acc[a][b][m][n] = (f32x4){0.f, 0.f, 0.f, 0.f};
    bf16x8 At[4][2], B0[2][2], B1[2][2];
    const char* cA = (const char*)g.A + (size_t)cur.pm * tstepA; const char* cB = (const char*)g.Bt + (size_t)cur.pn * tstepB;
    PG8_STAGE(PG8_SB(0, 0), cB, voffB); PG8_STAGE(PG8_SB(0, 1), cB + hstepB, voffB); PG8_STAGE(PG8_SA(0, 0), cA, voffA); PG8_STAGE(PG8_SA(0, 1), cA + hstepA, voffA);
    if (wr == 1) PG8_BAR;
    PG8_WAIT_V(2); PG8_BAR;
    PG8_STAGE(PG8_SB(1, 0), cB + kstep, voffB); PG8_STAGE(PG8_SA(1, 0), cA + kstep, voffA); PG8_STAGE(PG8_SB(1, 1), cB + hstepB + kstep, voffB);
    PG8_WAIT_V(6); PG8_BAR;
    for (;;) {
        const bool has_next = S.next(ui + 1, nxt);
        const char* nA = has_next ? (const char*)g.A + (size_t)nxt.pm * tstepA : cA; const char* nB = has_next ? (const char*)g.Bt + (size_t)nxt.pn * tstepB : cB;
        for (int t = 0; t < nt; t += 2) {
            const bool last = (t == nt - 2);
            const char* a1 = cA + (size_t)(t + 1) * kstep;
            const char* a2 = last ? nA : cA + (size_t)(t + 2) * kstep; const char* b2 = last ? nB : cB + (size_t)(t + 2) * kstep;
            const char* a3 = a2 + kstep; const char* b3 = b2 + kstep;
            PG8_LDB(B0, 0, 0); PG8_LDB(B1, 0, 1); PG8_SCHED; PG8_LDA(At, 0, 0); PG8_STAGE(PG8_SA(1, 1), a1 + hstepA, voffA);
            PG8_WAIT_V(8); PG8_WAIT_L(0); PG8_BAR; PG8_MMA(0, 0, At, B0); PG8_MMA(0, 1, At, B1); PG8_BAR; PG8_SCHED;
            PG8_LDA(At, 0, 1); PG8_STAGE(PG8_SB(0, 0), b2, voffB); PG8_STAGE(PG8_SB(0, 1), b2 + hstepB, voffB); PG8_STAGE(PG8_SA(0, 0), a2, voffA);
            PG8_WAIT_V(8); PG8_WAIT_L(0); PG8_BAR; PG8_MMA(1, 0, At, B0); PG8_MMA(1, 1, At, B1); PG8_BAR; PG8_SCHED;
            PG8_LDB(B0, 1, 0); PG8_LDB(B1, 1, 1); PG8_SCHED; PG8_LDA(At, 1, 0); PG8_STAGE(PG8_SA(0, 1), a2 + hstepA, voffA);
            PG8_WAIT_V(8); PG8_WAIT_L(0); PG8_BAR; PG8_MMA(0, 0, At, B0); PG8_MMA(0, 1, At, B1); PG8_BAR; PG8_SCHED;
            PG8_LDA(At, 1, 1); PG8_STAGE(PG8_SB(1, 0), b3, voffB); PG8_STAGE(PG8_SB(1, 1), b3 + hstepB, voffB); PG8_STAGE(PG8_SA(1, 0), a3, voffA);
            PG8_WAIT_V(8); PG8_WAIT_L(0); PG8_BAR; PG8_MMA(1, 0, At, B0); PG8_MMA(1, 1, At, B1); PG8_BAR; PG8_SCHED;
        }
        if constexpr (ALIGN_EPI) { if (wr == 0) PG8_BAR; }
        E(acc, cur, wr, wc, fr, fq);
        if (!has_next) break;
#pragma unroll
        for (int a = 0; a < 2; ++a)
#pragma unroll
            for (int b = 0; b < 2; ++b)
#pragma unroll
                for (int m = 0; m < 4; ++m)
#pragma unroll
                    for (int n = 0; n < 2; ++n) acc[a][b][m][n] = (f32x4){0.f, 0.f, 0.f, 0.f};
        cur = nxt; cA = nA; cB = nB; ++ui;
        if constexpr (ALIGN_EPI) { if (wr == 1) PG8_BAR; }
    }
    PG8_WAIT_V(0);
    if constexpr (!ALIGN_EPI) { if (wr == 0) PG8_BAR; }
    PG8_BAR;
#undef PG8_SA
#undef PG8_SB
#undef PG8_STAGE
#undef PG8_LDA
#undef PG8_LDB
#undef PG8_MMA
#undef PG8_WAIT_V
#undef PG8_WAIT_L
#undef PG8_BAR
#undef PG8_SCHED
}
}

namespace att2 {
constexpr int KBUF = 64 * 384, VBUF = 128 * 128;
constexpr int L_K = 0, L_V = 2 * KBUF, L_WS = L_V + 2 * VBUF, L_END = L_WS + 8 * 128;
constexpr float THR = 8.0f;
typedef float f32x2_t __attribute__((ext_vector_type(2))); typedef __bf16 bf16x2_t __attribute__((ext_vector_type(2)));
__device__ __forceinline__ unsigned cvtpk(float lo, float hi) { f32x2_t v = {lo, hi}; bf16x2_t b = __builtin_convertvector(v, bf16x2_t); return __builtin_bit_cast(unsigned, b); }
__device__ __forceinline__ int kperm(int r) { return (r & ~12) | ((r & 4) << 1) | ((r & 8) >> 1); }
#define SGB(m, n) __builtin_amdgcn_sched_group_barrier(m, n, 0)
__device__ __forceinline__ float rowmax32(const f32x16& a, const f32x16& b) {
    float x = __builtin_fmaxf(__builtin_fmaxf(a[0], a[1]), b[0]), y = __builtin_fmaxf(__builtin_fmaxf(a[2], a[3]), b[1]);
    x = __builtin_fmaxf(__builtin_fmaxf(x, b[2]), b[3]);
#pragma unroll
    for (int r = 4; r < 16; r += 4) { x = __builtin_fmaxf(__builtin_fmaxf(x, a[r]), a[r + 1]); y = __builtin_fmaxf(__builtin_fmaxf(y, a[r + 2]), a[r + 3]);
        x = __builtin_fmaxf(__builtin_fmaxf(x, b[r]), b[r + 1]); y = __builtin_fmaxf(__builtin_fmaxf(y, b[r + 2]), b[r + 3]); }
    return __builtin_fmaxf(x, y);
}
__device__ __forceinline__ float xhalf_max(float m) { auto rr = __builtin_amdgcn_permlane32_swap(__float_as_uint(m), __float_as_uint(m), false, false); return __builtin_fmaxf(__uint_as_float(rr[0]), __uint_as_float(rr[1])); }

__device__ __forceinline__ void attn_unit(LAS unsigned char* lds, int b, int h, int qb, const bf16_t* __restrict__ Q, const bf16_t* __restrict__ Kg, const bf16_t* __restrict__ VT, bf16_t* __restrict__ O, const float* __restrict__ gq, const float* __restrict__ rope) {
    int tid = threadIdx.x; asm volatile("" : "+v"(tid));
    const int lane = tid & 63, r32 = lane & 31, hh = lane >> 5; const int wid = __builtin_amdgcn_readfirstlane(tid >> 6);
    const int q0 = qb * 256, q0w = q0 + wid * 32;
    const size_t tokb = (size_t)b * SEQ;
    const int NT = (q0 + 256) / 64;
    const int my_last = (q0w + 31) / 64;
    unsigned kgo[3], vgo[2];
#pragma unroll
    for (int i = 0; i < 3; ++i) { const int slot = (wid * 3 + i) * 64 + lane, row = slot / 24, cc = slot % 24, c = (cc & ~7) | ((cc & 7) ^ ((row >> 1) & 7)); kgo[i] = (unsigned)(row * QW + c * 8) * 2u; }
#pragma unroll
    for (int i = 0; i < 2; ++i) { const int slot = (wid * 2 + i) * 64 + lane, d = slot >> 3, cc = slot & 7, c = cc ^ ((d >> 1) & 7); vgo[i] = (unsigned)(d * MT + c * 8) * 2u; }
    const char* kbase = (const char*)(Kg + tokb * QW + h * DQK);
    const char* vbase = (const char*)(VT + (size_t)(h * DV) * MT + tokb);
#define A2_DMA_K(t, buf) do { _Pragma("unroll") for (int i = 0; i < 3; ++i) __builtin_amdgcn_global_load_lds((const unsigned*)(kbase + (size_t)(t) * (64 * QW * 2) + kgo[i]), \
        (LAS unsigned*)(lds + L_K + (buf) * KBUF + (wid * 3 + i) * 1024), 16, 0, 0); } while (0)
#define A2_DMA_V(t, buf) do { _Pragma("unroll") for (int i = 0; i < 2; ++i) __builtin_amdgcn_global_load_lds((const unsigned*)(vbase + (size_t)(t) * 128 + vgo[i]), \
        (LAS unsigned*)(lds + L_V + (buf) * VBUF + (wid * 2 + i) * 1024), 16, 0, 0); } while (0)
    A2_DMA_K(0, 0); A2_DMA_V(0, 0); if (NT > 1) A2_DMA_K(1, 1);
    bf16x8 qf[12];
    { const bf16_t* qp = Q + (tokb + q0w + r32) * QW + h * DQK + hh * 8;
#pragma unroll
      for (int st = 0; st < 12; ++st) qf[st] = *(const bf16x8*)(qp + st * 16);
      float ss = 0.f;
#pragma unroll
      for (int st = 0; st < 12; ++st) { const u32x4 w = __builtin_bit_cast(u32x4, qf[st]);
          ss += bflo(w.x) * bflo(w.x) + bfhi(w.x) * bfhi(w.x) + bflo(w.y) * bflo(w.y) + bfhi(w.y) * bfhi(w.y) + bflo(w.z) * bflo(w.z) + bfhi(w.z) * bfhi(w.z) + bflo(w.w) * bflo(w.w) + bfhi(w.w) * bfhi(w.w); }
      { auto rr = __builtin_amdgcn_permlane32_swap(__float_as_uint(ss), __float_as_uint(ss), false, false); ss = __uint_as_float(rr[0]) + __uint_as_float(rr[1]); }
      const float rs = rsqrtf(ss * (1.0f / DQK) + EPS) * QSCALE;
      const float* gp = gq + 8 * hh;
      const float* rp = rope + (tokb + q0w + r32) * 64 + 8 * hh;
#pragma unroll
      for (int st = 0; st < 8; ++st) { const u32x4 w = __builtin_bit_cast(u32x4, qf[st]);
          u32x4 o; o.x = cvtpk(bflo(w.x) * rs, bfhi(w.x) * rs); o.y = cvtpk(bflo(w.y) * rs, bfhi(w.y) * rs);
          o.z = cvtpk(bflo(w.z) * rs, bfhi(w.z) * rs); o.w = cvtpk(bflo(w.w) * rs, bfhi(w.w) * rs);
          qf[st] = __builtin_bit_cast(bf16x8, o); }
#pragma unroll
      for (int st = 8; st < 10; ++st) {
          const u32x4 w1 = __builtin_bit_cast(u32x4, qf[st]), w2 = __builtin_bit_cast(u32x4, qf[st + 2]);
          const f32x4 ga0 = *(const f32x4*)(gp + 16 * st), ga1 = *(const f32x4*)(gp + 16 * st + 4), gb0 = *(const f32x4*)(gp + 16 * st + 32), gb1 = *(const f32x4*)(gp + 16 * st + 36);
          const f32x4 c0 = *(const f32x4*)(rp + 16 * (st - 8)), c1 = *(const f32x4*)(rp + 16 * (st - 8) + 4), s0 = *(const f32x4*)(rp + 32 + 16 * (st - 8)), s1 = *(const f32x4*)(rp + 32 + 16 * (st - 8) + 4);
          float x1[8], x2[8], cs[8], sn[8];
          x1[0] = bflo(w1.x) * rs * ga0.x; x1[1] = bfhi(w1.x) * rs * ga0.y; x1[2] = bflo(w1.y) * rs * ga0.z; x1[3] = bfhi(w1.y) * rs * ga0.w;
          x1[4] = bflo(w1.z) * rs * ga1.x; x1[5] = bfhi(w1.z) * rs * ga1.y; x1[6] = bflo(w1.w) * rs * ga1.z; x1[7] = bfhi(w1.w) * rs * ga1.w;
          x2[0] = bflo(w2.x) * rs * gb0.x; x2[1] = bfhi(w2.x) * rs * gb0.y; x2[2] = bflo(w2.y) * rs * gb0.z; x2[3] = bfhi(w2.y) * rs * gb0.w;
          x2[4] = bflo(w2.z) * rs * gb1.x; x2[5] = bfhi(w2.z) * rs * gb1.y; x2[6] = bflo(w2.w) * rs * gb1.z; x2[7] = bfhi(w2.w) * rs * gb1.w;
          cs[0] = c0.x; cs[1] = c0.y; cs[2] = c0.z; cs[3] = c0.w; cs[4] = c1.x; cs[5] = c1.y; cs[6] = c1.z; cs[7] = c1.w;
          sn[0] = s0.x; sn[1] = s0.y; sn[2] = s0.z; sn[3] = s0.w; sn[4] = s1.x; sn[5] = s1.y; sn[6] = s1.z; sn[7] = s1.w;
          float y1[8], y2[8];
#pragma unroll
          for (int i = 0; i < 8; ++i) { y1[i] = x1[i] * cs[i] - x2[i] * sn[i]; y2[i] = x2[i] * cs[i] + x1[i] * sn[i]; }
          u32x4 o1, o2; o1.x = cvtpk(y1[0], y1[1]); o1.y = cvtpk(y1[2], y1[3]); o1.z = cvtpk(y1[4], y1[5]); o1.w = cvtpk(y1[6], y1[7]);
          o2.x = cvtpk(y2[0], y2[1]); o2.y = cvtpk(y2[2], y2[3]); o2.z = cvtpk(y2[4], y2[5]); o2.w = cvtpk(y2[6], y2[7]);
          qf[st] = __builtin_bit_cast(bf16x8, o1); qf[st + 2] = __builtin_bit_cast(bf16x8, o2); }
    }
    __builtin_amdgcn_sched_barrier(0);
    int ka[4], va[4];
    { const int row = kperm(r32), g = (row >> 1) & 7;
#pragma unroll
      for (int j = 0; j < 4; ++j) ka[j] = L_K + row * 384 + (((2 * j + hh) ^ g) * 16);
      const int gv = (r32 >> 1) & 7;
#pragma unroll
      for (int sI = 0; sI < 4; ++sI) va[sI] = L_V + r32 * 128 + (((2 * sI + hh) ^ gv) * 16); }
#define A2_KF(buf, st, half) (*(const LAS bf16x8*)(lds + ka[(st) & 3] + (buf) * KBUF + ((st) >> 2) * 128 + (half) * (32 * 384)))
#define A2_VF(buf, db, sI) (*(const LAS bf16x8*)(lds + va[sI] + (buf) * VBUF + (db) * (32 * 128)))
    f32x16 o[4];
#pragma unroll
    for (int d = 0; d < 4; ++d)
#pragma unroll
        for (int r = 0; r < 16; ++r) o[d][r] = 0.f;
    float m_run = 0.f, l_run = 0.f;
    f32x16 negm;
#pragma unroll
    for (int r = 0; r < 16; ++r) negm[r] = 0.f;
    LAS float* wsf = (LAS float*)(lds + L_WS + wid * 128);
    asm volatile("s_waitcnt vmcnt(0)" ::: "memory");
    __syncthreads();
    if (wid >= 4) __builtin_amdgcn_s_setprio(1);
    f32x16 s0, s1;
    { s0 = negm; s1 = negm;
#pragma unroll
      for (int st = 0; st < 12; ++st) { s0 = __builtin_amdgcn_mfma_f32_32x32x16_bf16(A2_KF(0, st, 0), qf[st], s0, 0, 0, 0); s1 = __builtin_amdgcn_mfma_f32_32x32x16_bf16(A2_KF(0, st, 1), qf[st], s1, 0, 0, 0); }
      if (63 > q0w) { const int qi = q0w + r32, kv0 = 8 * hh;
#pragma unroll
          for (int r = 0; r < 16; ++r) { const int kv = kv0 + (r & 7) + 16 * (r >> 3); if (kv > qi) s0[r] = -1e30f; if (kv + 32 > qi) s1[r] = -1e30f; } }
      const float rm = xhalf_max(rowmax32(s0, s1));
      m_run = rm;
#pragma unroll
      for (int r = 0; r < 16; ++r) { s0[r] -= rm; s1[r] -= rm; negm[r] = -rm; }
    }
    asm volatile("s_waitcnt lgkmcnt(0)" ::: "memory");
    __builtin_amdgcn_s_barrier();
    asm volatile("" ::: "memory");
    for (int t = 0; t < NT; ++t) {
        const int cb = t & 1, nb = cb ^ 1;
        if (t + 2 < NT) A2_DMA_K(t + 2, cb);
        if (t + 1 < NT) A2_DMA_V(t + 1, nb);
        if (t <= my_last) {
            const bool has_next = (t + 1 <= my_last);
            f32x16 n0 = negm, n1 = negm;
            bf16x8 pf[4];
            float ls = 0.f;
            if (has_next) {
#pragma unroll
                for (int st = 0; st < 12; ++st) { n0 = __builtin_amdgcn_mfma_f32_32x32x16_bf16(A2_KF(nb, st, 0), qf[st], n0, 0, 0, 0); n1 = __builtin_amdgcn_mfma_f32_32x32x16_bf16(A2_KF(nb, st, 1), qf[st], n1, 0, 0, 0); }
            }
#pragma unroll
            for (int r = 0; r < 16; ++r) { s0[r] = __builtin_amdgcn_exp2f(s0[r]); s1[r] = __builtin_amdgcn_exp2f(s1[r]); }
#pragma unroll
            for (int r = 0; r < 16; ++r) ls += s0[r] + s1[r];
#pragma unroll
            for (int sI = 0; sI < 4; ++sI) { u32x4 w;
                if (sI < 2) { w.x = cvtpk(s0[8 * sI + 0], s0[8 * sI + 1]); w.y = cvtpk(s0[8 * sI + 2], s0[8 * sI + 3]); w.z = cvtpk(s0[8 * sI + 4], s0[8 * sI + 5]); w.w = cvtpk(s0[8 * sI + 6], s0[8 * sI + 7]); }
                else { const int s2 = sI - 2; w.x = cvtpk(s1[8 * s2 + 0], s1[8 * s2 + 1]); w.y = cvtpk(s1[8 * s2 + 2], s1[8 * s2 + 3]); w.z = cvtpk(s1[8 * s2 + 4], s1[8 * s2 + 5]); w.w = cvtpk(s1[8 * s2 + 6], s1[8 * s2 + 7]); }
                pf[sI] = __builtin_bit_cast(bf16x8, w); }
            l_run += ls;
            if (has_next) {
                SGB(0x100, 4);
#pragma unroll
                for (int i = 0; i < 20; ++i) { SGB(0x008, 1); SGB(0x100, 1); SGB(0x002, 4); }
#pragma unroll
                for (int i = 0; i < 4; ++i) { SGB(0x008, 1); SGB(0x002, 4); }
                __builtin_amdgcn_sched_barrier(0);
                if ((t + 1) * 64 + 63 > q0w) { const int qi = q0w + r32, kv0 = (t + 1) * 64 + 8 * hh;
#pragma unroll
                    for (int r = 0; r < 16; ++r) { const int kv = kv0 + (r & 7) + 16 * (r >> 3); if (kv > qi) n0[r] = -1e30f; if (kv + 32 > qi) n1[r] = -1e30f; } }
                __builtin_amdgcn_sched_barrier(0);
            }
#pragma unroll
            for (int sI = 0; sI < 4; ++sI)
#pragma unroll
                for (int d = 0; d < 4; ++d) o[d] = __builtin_amdgcn_mfma_f32_32x32x16_bf16(pf[sI], A2_VF(cb, d, sI), o[d], 0, 0, 0);
            float rm = -1e30f;
            if (has_next) rm = xhalf_max(rowmax32(n0, n1));
            SGB(0x100, 4);
#pragma unroll
            for (int i = 0; i < 12; ++i) { SGB(0x008, 1); SGB(0x100, 1); SGB(0x002, 2); }
#pragma unroll
            for (int i = 0; i < 4; ++i) { SGB(0x008, 1); SGB(0x002, 2); }
            __builtin_amdgcn_sched_barrier(0);
            if (__any(rm > THR)) {
                const float dl = __builtin_fmaxf(rm, 0.f), al = __builtin_amdgcn_exp2f(-dl);
                m_run += dl; l_run *= al;
#pragma unroll
                for (int r = 0; r < 16; ++r) { n0[r] -= dl; n1[r] -= dl; negm[r] = -m_run; }
                if (hh == 0) wsf[r32] = al;
                asm volatile("s_waitcnt lgkmcnt(0)" ::: "memory");
#pragma unroll
                for (int g = 0; g < 4; ++g) { const f32x4 a4 = *(const LAS f32x4*)(wsf + 8 * g + 4 * hh);
#pragma unroll
                    for (int d = 0; d < 4; ++d) { o[d][4 * g + 0] *= a4.x; o[d][4 * g + 1] *= a4.y; o[d][4 * g + 2] *= a4.z; o[d][4 * g + 3] *= a4.w; } }
                asm volatile("s_waitcnt lgkmcnt(0)" ::: "memory");
            }
            s0 = n0; s1 = n1;
        }
        asm volatile("s_waitcnt vmcnt(0) lgkmcnt(0)" ::: "memory");
        __builtin_amdgcn_s_barrier();
        asm volatile("" ::: "memory");
    }
    __builtin_amdgcn_s_setprio(0);
    l_run += __shfl_xor(l_run, 32);
    if (hh == 0) wsf[r32] = 1.0f / l_run;
    asm volatile("s_waitcnt lgkmcnt(0)" ::: "memory");
    LAS bf16_t* stg = (LAS bf16_t*)(lds + wid * 8192);
#pragma unroll
    for (int g = 0; g < 4; ++g) { const f32x4 a4 = *(const LAS f32x4*)(wsf + 8 * g + 4 * hh);
#pragma unroll
        for (int i = 0; i < 4; ++i) { const int row = 8 * g + 4 * hh + i; const float sc = (i == 0) ? a4.x : (i == 1) ? a4.y : (i == 2) ? a4.z : a4.w;
#pragma unroll
            for (int d = 0; d < 4; ++d) stg[row * 128 + d * 32 + r32] = (bf16_t)f2bf(o[d][4 * g + i] * sc); } }
    asm volatile("s_waitcnt lgkmcnt(0)" ::: "memory");
    { bf16_t* ob = O + (tokb + q0w) * DM + h * DV;
#pragma unroll
      for (int k = 0; k < 8; ++k) { const int chunk = k * 64 + lane, row = chunk >> 4, c16 = chunk & 15;
          const u32x4 v = *(const LAS u32x4*)(stg + row * 128 + c16 * 8); *(u32x4*)(ob + (size_t)row * DM + c16 * 8) = v; } }
    asm volatile("s_waitcnt lgkmcnt(0)" ::: "memory");
    __builtin_amdgcn_s_barrier();
    asm volatile("" ::: "memory");
#undef A2_DMA_K
#undef A2_DMA_V
#undef A2_KF
#undef A2_VF
}
__device__ __forceinline__ void attn_phase(LAS unsigned char* lds, int vcu, int G, const bf16_t* Q, const bf16_t* Kg, const bf16_t* VT, bf16_t* O, const float* gq, const float* rope) {
    for (int p = vcu; p < 256; p += G) {
        const int bh = p >> 4, s = p & 15;
        attn_unit(lds, bh >> 3, bh & 7, 31 - s, Q, Kg, VT, O, gq, rope);
        attn_unit(lds, bh >> 3, bh & 7, s, Q, Kg, VT, O, gq, rope);
    }
}
#undef SGB
}

__device__ __forceinline__ void transpose_item(const float* __restrict__ W, int N, int k0, int n0, bf16_t* dst, int ldk, const float* __restrict__ gain, LAS float* scr, int lane) {
    f32x4 v[8]; float gv[8];
#pragma unroll
    for (int i = 0; i < 8; ++i) { const int kk = 8 * i + (lane >> 3); v[i] = *(const f32x4*)(W + (size_t)(k0 + kk) * N + n0 + (lane & 7) * 4); gv[i] = gain ? gain[k0 + kk] : 1.0f; }
#pragma unroll
    for (int i = 0; i < 8; ++i) { const int kk = 8 * i + (lane >> 3); LAS float* p = scr + kk * 33 + (lane & 7) * 4; p[0] = v[i].x * gv[i]; p[1] = v[i].y * gv[i]; p[2] = v[i].z * gv[i]; p[3] = v[i].w * gv[i]; }
    asm volatile("s_waitcnt lgkmcnt(0)" ::: "memory");
    const int c = lane & 7;
#pragma unroll
    for (int j = 0; j < 4; ++j) { const int n = (lane >> 3) + 8 * j; const LAS float* s = scr + (8 * c) * 33 + n;
        u32x4 o; o.x = pk2(s[0 * 33], s[1 * 33]); o.y = pk2(s[2 * 33], s[3 * 33]); o.z = pk2(s[4 * 33], s[5 * 33]); o.w = pk2(s[6 * 33], s[7 * 33]);
        *(u32x4*)(dst + (size_t)n * ldk + k0 + 8 * c) = o; }
    asm volatile("s_waitcnt lgkmcnt(0)" ::: "memory");
}
struct In {
    const float* x; const int* pos; const float *g_mix, *g_mlp, *w_down, *g_q_a, *g_kv_a, *w_uq, *w_ukv, *g_qn, *g_kn, *w_o, *c_w_in, *c_w, *c_w_out, *w1, *w2;
};
struct MlaW { bf16_t *wd, *wuq, *wuk, *wuvt, *wo; };
struct ConvW { bf16_t *win, *wout; };
__device__ __forceinline__ MlaW mla_w(unsigned char* ws, int j) { MlaW w; bf16_t* p = (bf16_t*)(ws + WS_WMIX + (size_t)j * WMLA_BYTES);
    w.wd = p; p += DOWNP * DM; w.wuq = p; p += QW * QLORA; w.wuk = p; p += 1024 * KVLORA; w.wuvt = p; p += 1024 * KVLORA; w.wo = p; return w; }
__device__ __forceinline__ ConvW conv_w(unsigned char* ws, int j) { ConvW w; bf16_t* p = (bf16_t*)(ws + WS_WCONV + (size_t)j * WCONV_BYTES); w.win = p; w.wout = p + 3 * DM * DM; return w; }

__device__ __forceinline__ void convert_mlp(const In& in, unsigned char* ws, int L, LAS float* scr, int gw, int NGW, int lane) {
    bf16_t* w1t = (bf16_t*)(ws + WS_WMLP); bf16_t* w2t = w1t + (size_t)FF * DM;
    const float* w1 = in.w1 + (size_t)L * DM * FF; const float* w2 = in.w2 + (size_t)L * FF * DM; const float* g = in.g_mlp + L * DM;
    constexpr int I1 = (DM / 64) * (FF / 32), I2 = (FF / 64) * (DM / 32);
    for (int it = gw; it < I1 + I2; it += NGW) {
        if (it < I1) { const int kb = it / (FF / 32), nb = it % (FF / 32); transpose_item(w1, FF, kb * 64, nb * 32, w1t + (size_t)(nb * 32) * DM, DM, g, scr, lane); }
        else { const int r = it - I1, kb = r / (DM / 32), nb = r % (DM / 32); transpose_item(w2, DM, kb * 64, nb * 32, w2t + (size_t)(nb * 32) * FF, FF, nullptr, scr, lane); }
    }
}
__device__ __forceinline__ void convert_conv(const In& in, unsigned char* ws, int j, LAS float* scr, int gw, int NGW, int lane) {
    constexpr int I_IN = (DM / 64) * (3 * DM / 32), I_OUT = (DM / 64) * (DM / 32);
    const ConvW w = conv_w(ws, j);
    for (int r = gw; r < I_IN + I_OUT; r += NGW) {
        if (r < I_IN) { const int kb = r / (3 * DM / 32), nb = r % (3 * DM / 32), n0 = nb * 32;
            const int part = n0 >> 10, ch0 = n0 & 1023, drow = (part == 0) ? n0 : (1024 + (ch0 >> 7) * 256 + (part - 1) * 128 + (ch0 & 127));
            transpose_item(in.c_w_in + (size_t)j * DM * 3 * DM, 3 * DM, kb * 64, n0, w.win + (size_t)drow * DM, DM, in.g_mix + (2 * j + 1) * DM, scr, lane); }
        else { const int q = r - I_IN, kb = q / (DM / 32), nb = q % (DM / 32); transpose_item(in.c_w_out + (size_t)j * DM * DM, DM, kb * 64, nb * 32, w.wout + (size_t)(nb * 32) * DM, DM, nullptr, scr, lane); }
    }
}
__device__ __forceinline__ void prologue(const In& in, unsigned char* ws, LAS unsigned char* lds, int vcu, int G, int tid) {
    const int lane = tid & 63, wave = tid >> 6, gw = vcu * 8 + wave, NGW = G * 8;
    LAS float* scr = (LAS float*)(lds + wave * 16384);
    constexpr int I_D = (DM / 64) * (DOWN / 32), I_Q = (QLORA / 64) * (QW / 32), I_KV = (KVLORA / 64) * (2048 / 32), I_O = (DM / 64) * (DM / 32);
    constexpr int I_MLA = I_D + I_Q + I_KV + I_O;
    constexpr int I_IN = (DM / 64) * (3 * DM / 32), I_OUT = I_O, I_CONV = I_IN + I_OUT;
    for (int it = gw; it < 2 * I_MLA; it += NGW) {
        const int j = it / I_MLA; int r = it % I_MLA; const MlaW w = mla_w(ws, j);
        if (r < I_D) { const int kb = r / (DOWN / 32), nb = r % (DOWN / 32); transpose_item(in.w_down + (size_t)j * DM * DOWN, DOWN, kb * 64, nb * 32, w.wd + (size_t)(nb * 32) * DM, DM, in.g_mix + (2 * j) * DM, scr, lane); continue; } r -= I_D;
        if (r < I_Q) { const int kb = r / (QW / 32), nb = r % (QW / 32); transpose_item(in.w_uq + (size_t)j * QLORA * QW, QW, kb * 64, nb * 32, w.wuq + (size_t)(nb * 32) * QLORA, QLORA, in.g_q_a + j * QLORA, scr, lane); continue; } r -= I_Q;
        if (r < I_KV) { const int kb = r / 64, nb = r % 64, n0 = nb * 32, hd = n0 >> 8, j0 = n0 & 255;
            bf16_t* dst = (j0 < 128) ? (w.wuk + (size_t)(hd * 128 + j0) * KVLORA) : (w.wuvt + (size_t)(hd * 128 + j0 - 128) * KVLORA);
            transpose_item(in.w_ukv + (size_t)j * KVLORA * 2048, 2048, kb * 64, n0, dst, KVLORA, in.g_kv_a + j * KVLORA, scr, lane); continue; } r -= I_KV;
        { const int kb = r / (DM / 32), nb = r % (DM / 32); transpose_item(in.w_o + (size_t)j * DM * DM, DM, kb * 64, nb * 32, w.wo + (size_t)(nb * 32) * DM, DM, nullptr, scr, lane); }
    }
    { const int gt = vcu * 512 + tid, NT = G * 512;
      for (int i = gt; i < 2 * (DOWNP - DOWN) * DM / 8; i += NT) { const int j = i / ((DOWNP - DOWN) * DM / 8), r = i % ((DOWNP - DOWN) * DM / 8);
          *(u32x4*)(mla_w(ws, j).wd + (size_t)DOWN * DM + (size_t)r * 8) = (u32x4){0u, 0u, 0u, 0u}; }
      float* rope = (float*)(ws + WS_ROPE);
      for (int i = gt; i < MT * 32; i += NT) { const int tok = i >> 5, f = i & 31;
          const float inv = (float)exp2(-(double)f * (13.287712379549449 / 32.0));
          const float ang = (float)in.pos[tok] * inv;
          float sn_, cs_; sincosf(ang, &sn_, &cs_);
          rope[(size_t)tok * 64 + f] = cs_; rope[(size_t)tok * 64 + 32 + f] = sn_; }
    }
    bf16_t* xb = (bf16_t*)(ws + WS_XA); float* ssx = (float*)(ws + WS_SSX);
    for (int m = gw; m < MT; m += 2 * NGW) {
        const int m2 = m + NGW; const bool has2 = m2 < MT;
        const f32x4* xr = (const f32x4*)(in.x + (size_t)m * DM) + lane; const f32x4* xr2 = (const f32x4*)(in.x + (size_t)(has2 ? m2 : m) * DM) + lane;
        f32x4 va[4], vb[4];
#pragma unroll
        for (int j = 0; j < 4; ++j) { va[j] = xr[64 * j]; vb[j] = xr2[64 * j]; }
        float s = 0.f, s2 = 0.f;
        unsigned long long* o8 = (unsigned long long*)(xb + (size_t)m * DM) + lane; unsigned long long* o82 = (unsigned long long*)(xb + (size_t)m2 * DM) + lane;
#pragma unroll
        for (int j = 0; j < 4; ++j) { const f32x4 v = va[j]; s += (v.x * v.x + v.y * v.y) + (v.z * v.z + v.w * v.w);
            o8[64 * j] = (unsigned long long)pk2(v.x, v.y) | ((unsigned long long)pk2(v.z, v.w) << 32); }
        if (has2) {
#pragma unroll
            for (int j = 0; j < 4; ++j) { const f32x4 v = vb[j]; s2 += (v.x * v.x + v.y * v.y) + (v.z * v.z + v.w * v.w);
                o82[64 * j] = (unsigned long long)pk2(v.x, v.y) | ((unsigned long long)pk2(v.z, v.w) << 32); }
        }
        s = wave_sum(s); s2 = wave_sum(s2);
        if (lane < 16) { ssx[(size_t)m * 16 + lane] = (lane == 0) ? s : 0.f; if (has2) ssx[(size_t)m2 * 16 + lane] = (lane == 0) ? s2 : 0.f; }
    }
}
__device__ __forceinline__ void qk_head24(u32x4& c0, u32x4& c1, u32x4& c2, const float (&g)[24], const float (&cs)[8], const float (&sn)[8], int s, float osc) {
    float e[24];
    e[0] = bflo(c0.x); e[1] = bfhi(c0.x); e[2] = bflo(c0.y); e[3] = bfhi(c0.y); e[4] = bflo(c0.z); e[5] = bfhi(c0.z); e[6] = bflo(c0.w); e[7] = bfhi(c0.w);
    e[8] = bflo(c1.x); e[9] = bfhi(c1.x); e[10] = bflo(c1.y); e[11] = bfhi(c1.y); e[12] = bflo(c1.z); e[13] = bfhi(c1.z); e[14] = bflo(c1.w); e[15] = bfhi(c1.w);
    e[16] = bflo(c2.x); e[17] = bfhi(c2.x); e[18] = bflo(c2.y); e[19] = bfhi(c2.y); e[20] = bflo(c2.z); e[21] = bfhi(c2.z); e[22] = bflo(c2.w); e[23] = bfhi(c2.w);
    float ss = 0.f;
#pragma unroll
    for (int i = 0; i < 24; ++i) ss += e[i] * e[i];
    ss += __shfl_xor(ss, 1); ss += __shfl_xor(ss, 2); ss += __shfl_xor(ss, 4);
    const float rs = rsqrtf(ss * (1.0f / DQK) + EPS);
#pragma unroll
    for (int i = 0; i < 24; ++i) e[i] = e[i] * rs * g[i];
#pragma unroll
    for (int i = 0; i < 8; ++i) { const float pr = __shfl_xor(e[16 + i], 4); e[16 + i] = (s < 4) ? (e[16 + i] * cs[i] - pr * sn[i]) : (e[16 + i] * cs[i] + pr * sn[i]); }
#pragma unroll
    for (int i = 0; i < 24; ++i) e[i] *= osc;
    c0.x = pk2(e[0], e[1]); c0.y = pk2(e[2], e[3]); c0.z = pk2(e[4], e[5]); c0.w = pk2(e[6], e[7]);
    c1.x = pk2(e[8], e[9]); c1.y = pk2(e[10], e[11]); c1.z = pk2(e[12], e[13]); c1.w = pk2(e[14], e[15]);
    c2.x = pk2(e[16], e[17]); c2.y = pk2(e[18], e[19]); c2.z = pk2(e[20], e[21]); c2.w = pk2(e[22], e[23]);
}
__device__ __forceinline__ void knorm_unit(const float* __restrict__ gk, const float* __restrict__ gq, const float* __restrict__ rope, bf16_t* kb, const bf16_t* __restrict__ a, int pm, int pn, int tid) {
    const int lane = tid & 63, wave = tid >> 6, slot = lane >> 3, s = lane & 7;
    float gkv[24];
#pragma unroll
    for (int c = 0; c < 3; ++c)
#pragma unroll
        for (int i = 0; i < 8; ++i) gkv[8 * c + i] = gk[64 * c + 8 * s + i] * (c < 2 ? gq[64 * c + 8 * s + i] : 1.0f);
#pragma unroll 1
    for (int bt = 0; bt < 2; ++bt) {
        u32x4 k0[4], k1[4], k2[4]; f32x4 rc[4][2], rsn[4][2];
#pragma unroll
        for (int q4 = 0; q4 < 4; ++q4) { const int it = bt * 4 + q4, tok = pm * 256 + wave * 32 + it * 4 + (slot >> 1), hd = 2 * pn + (slot & 1);
            const bf16_t* kr = kb + (size_t)tok * QW + hd * DQK + 8 * s;
            k0[q4] = *(const u32x4*)(kr); k1[q4] = *(const u32x4*)(kr + 64); k2[q4] = *(const u32x4*)(a + (size_t)tok * DOWNP + 384 + 8 * s);
            rc[q4][0] = *(const f32x4*)(rope + (size_t)tok * 64 + 8 * (s & 3)); rc[q4][1] = *(const f32x4*)(rope + (size_t)tok * 64 + 8 * (s & 3) + 4);
            rsn[q4][0] = *(const f32x4*)(rope + (size_t)tok * 64 + 32 + 8 * (s & 3)); rsn[q4][1] = *(const f32x4*)(rope + (size_t)tok * 64 + 32 + 8 * (s & 3) + 4); }
        asm volatile("" ::: "memory");
#pragma unroll
        for (int q4 = 0; q4 < 4; ++q4) { const int it = bt * 4 + q4, tok = pm * 256 + wave * 32 + it * 4 + (slot >> 1), hd = 2 * pn + (slot & 1);
            bf16_t* kr = kb + (size_t)tok * QW + hd * DQK + 8 * s;
            float cs[8], sn[8];
            cs[0] = rc[q4][0].x; cs[1] = rc[q4][0].y; cs[2] = rc[q4][0].z; cs[3] = rc[q4][0].w; cs[4] = rc[q4][1].x; cs[5] = rc[q4][1].y; cs[6] = rc[q4][1].z; cs[7] = rc[q4][1].w;
            sn[0] = rsn[q4][0].x; sn[1] = rsn[q4][0].y; sn[2] = rsn[q4][0].z; sn[3] = rsn[q4][0].w; sn[4] = rsn[q4][1].x; sn[5] = rsn[q4][1].y; sn[6] = rsn[q4][1].z; sn[7] = rsn[q4][1].w;
            qk_head24(k0[q4], k1[q4], k2[q4], gkv, cs, sn, s, 1.0f);
            *(u32x4*)(kr) = k0[q4]; *(u32x4*)(kr + 64) = k1[q4]; *(u32x4*)(kr + 128) = k2[q4]; }
        asm volatile("" ::: "memory");
    }
}
__device__ __forceinline__ void conv_gate(const float* __restrict__ cw  , const bf16_t* __restrict__ bcu, bf16_t* __restrict__ y, int vcu, int G, int tid) {
    constexpr int CHUNK = 16, LD = 2 * DM;
    const int gt = vcu * 512 + tid, NT = G * 512;
    for (int i = gt; i < (MT / CHUNK) * (DM / 8); i += NT) {
        const int c8 = (i & 127) * 8, tok0 = (i >> 7) * CHUNK, t0 = tok0 & (SEQ - 1);
        float w[3][8];
#pragma unroll
        for (int k = 0; k < 3; ++k) { const f32x4 a0 = *(const f32x4*)(cw + k * DM + c8), a1 = *(const f32x4*)(cw + k * DM + c8 + 4);
            w[k][0] = a0.x; w[k][1] = a0.y; w[k][2] = a0.z; w[k][3] = a0.w; w[k][4] = a1.x; w[k][5] = a1.y; w[k][6] = a1.z; w[k][7] = a1.w; }
        float p1[8], p2[8];
#pragma unroll
        for (int e = 0; e < 8; ++e) { p1[e] = 0.f; p2[e] = 0.f; }
        if (t0 > 0) {
            const u32x4 u2 = *(const u32x4*)(bcu + (size_t)(tok0 - 2) * LD + DM + c8), u1 = *(const u32x4*)(bcu + (size_t)(tok0 - 1) * LD + DM + c8);
            p2[0] = bflo(u2.x); p2[1] = bfhi(u2.x); p2[2] = bflo(u2.y); p2[3] = bfhi(u2.y); p2[4] = bflo(u2.z); p2[5] = bfhi(u2.z); p2[6] = bflo(u2.w); p2[7] = bfhi(u2.w);
            p1[0] = bflo(u1.x); p1[1] = bfhi(u1.x); p1[2] = bflo(u1.y); p1[3] = bfhi(u1.y); p1[4] = bflo(u1.z); p1[5] = bfhi(u1.z); p1[6] = bflo(u1.w); p1[7] = bfhi(u1.w);
        }
#pragma unroll 4
        for (int k = 0; k < CHUNK; ++k) {
            const bf16_t* row = bcu + (size_t)(tok0 + k) * LD;
            const u32x4 gb = *(const u32x4*)(row + c8), uc = *(const u32x4*)(row + DM + c8);
            float p0[8], gbf[8];
            p0[0] = bflo(uc.x); p0[1] = bfhi(uc.x); p0[2] = bflo(uc.y); p0[3] = bfhi(uc.y); p0[4] = bflo(uc.z); p0[5] = bfhi(uc.z); p0[6] = bflo(uc.w); p0[7] = bfhi(uc.w);
            gbf[0] = bflo(gb.x); gbf[1] = bfhi(gb.x); gbf[2] = bflo(gb.y); gbf[3] = bfhi(gb.y); gbf[4] = bflo(gb.z); gbf[5] = bfhi(gb.z); gbf[6] = bflo(gb.w); gbf[7] = bfhi(gb.w);
            float o[8];
#pragma unroll
            for (int e = 0; e < 8; ++e) { o[e] = gbf[e] * (w[0][e] * p2[e] + w[1][e] * p1[e] + w[2][e] * p0[e]); p2[e] = p1[e]; p1[e] = p0[e]; }
            u32x4 ov; ov.x = pk2(o[0], o[1]); ov.y = pk2(o[2], o[3]); ov.z = pk2(o[4], o[5]); ov.w = pk2(o[6], o[7]);
            *(u32x4*)(y + (size_t)(tok0 + k) * DM + c8) = ov;
        }
    }
}

#define XB_TMO      128
#define XB_XCNT(j)  (256  + 64 * (j))
#define XB_XSUB(j)  (1280 + 64 * (j))
#define XB_XGEN(j)  (2304 + 64 * (j))
#define XB_TOP      3328
#define XB_TOPGEN   3392
#define XCD_BAR_WORDS 3456
#define XB_SPIN_CAP (1u << 18)
__device__ __forceinline__ unsigned xb_ld(unsigned* p)              { return __hip_atomic_load(p, __ATOMIC_RELAXED, __HIP_MEMORY_SCOPE_AGENT); }
__device__ __forceinline__ unsigned xb_add(unsigned* p, unsigned v) { return __hip_atomic_fetch_add(p, v, __ATOMIC_RELAXED, __HIP_MEMORY_SCOPE_AGENT); }
__device__ __forceinline__ unsigned xb_xcc_id() { return (unsigned)__builtin_amdgcn_s_getreg((3 << 11) | 20) & 0xFu; }
#define XB_SPIN(cond, bar) do { unsigned _sp = 0; while (cond) { __builtin_amdgcn_s_sleep(1); \
    if ((++_sp & 255u) == 0u) { if (xb_ld(&(bar)[XB_TMO])) break; if (_sp > XB_SPIN_CAP) { atomicAdd(&(bar)[XB_TMO], 1u); break; } } } } while (0)
struct XcdBarrier { unsigned* bar; unsigned x; volatile LAS unsigned* st; };
__device__ __forceinline__ XcdBarrier xcd_barrier_post(unsigned* bar, volatile LAS unsigned* st) {
    XcdBarrier b; b.bar = bar; b.x = xb_xcc_id(); b.st = st;
    if (threadIdx.x == 0) (void)xb_add(&bar[XB_XCNT(b.x)], 1u);
    return b;
}
__device__ __forceinline__ void xcd_barrier_complete(unsigned* bar, unsigned x, unsigned& nloc, unsigned& nx) {
    const unsigned G = gridDim.x * gridDim.y * gridDim.z;
    unsigned sum, cnt, mine, sp = 0u;
    for (;;) {
        sum = 0u; cnt = 0u; mine = 0u;
#pragma unroll
        for (unsigned j = 0; j < 16; ++j) { const unsigned c = xb_ld(&bar[XB_XCNT(j)]); sum += c; cnt += (c > 0u) ? 1u : 0u; mine = (j == x) ? c : mine; }
        if (sum == G) break;
        __builtin_amdgcn_s_sleep(1);
        if ((++sp & 255u) == 0u) { if (xb_ld(&bar[XB_TMO])) break; if (sp > XB_SPIN_CAP) { atomicAdd(&bar[XB_TMO], 1u); break; } }
    }
    nloc = mine > 0u ? mine : 1u; nx = cnt > 0u ? cnt : 1u;
}
__device__ __forceinline__ void xcd_barrier(const XcdBarrier& b) {
    asm volatile("s_waitcnt vmcnt(0)" ::: "memory");
    __syncthreads();
    if (threadIdx.x == 0) {
        unsigned* bar = b.bar;
        __builtin_amdgcn_s_waitcnt(0);
        unsigned nloc = b.st[0], nx = b.st[1];
        if (nloc == 0u) { xcd_barrier_complete(bar, b.x, nloc, nx); b.st[0] = nloc; b.st[1] = nx; }
        const unsigned old = xb_add(&bar[XB_XSUB(b.x)], 1u);
        const unsigned gen = old / nloc;
        if (old + 1u == (gen + 1u) * nloc) {
            __builtin_amdgcn_fence(__ATOMIC_RELEASE, "agent");
            asm volatile("s_waitcnt vmcnt(0)" ::: "memory");
            const unsigned og = xb_add(&bar[XB_TOP], 1u);
            const unsigned tg = og / nx;
            if (og + 1u == (tg + 1u) * nx) xb_add(&bar[XB_TOPGEN], 1u);
            else XB_SPIN(xb_ld(&bar[XB_TOPGEN]) == tg, bar);
            __builtin_amdgcn_fence(__ATOMIC_ACQUIRE, "agent");
            xb_add(&bar[XB_XGEN(b.x)], 1u);
            asm volatile("s_waitcnt vmcnt(0)" ::: "memory");
        } else {
            XB_SPIN(xb_ld(&bar[XB_XGEN(b.x)]) == gen, bar);
            __builtin_amdgcn_fence(__ATOMIC_ACQUIRE, "agent");
            asm volatile("s_waitcnt vmcnt(0)" ::: "memory");
        }
    }
    __syncthreads();
}

constexpr int RING_BYTES = 131072, MISC_OFF = RING_BYTES + 320, LDS_BYTES = 147456;
static_assert(att2::L_END <= RING_BYTES && pg8::STAGE_BYTES <= RING_BYTES, "LDS map");
constexpr int PH_PER_LAYER = 7, NPH = 1 + NLAYER * PH_PER_LAYER;
struct Args { In in; float* out; unsigned char* ws; int ph_lo, ph_hi, nogemm, noattn; };

__global__ void __launch_bounds__(512, 2) mk_fwd(Args args) {
    extern __shared__ __attribute__((aligned(16))) unsigned char lds_raw[];
    LAS unsigned char* lds = (LAS unsigned char*)lds_raw;
    const int tid = threadIdx.x, G = gridDim.x, bx = blockIdx.x;
    const int vcu = (G % 8 == 0) ? (bx % 8) * (G / 8) + bx / 8 : bx;
    unsigned char* ws = args.ws; const In& in = args.in;
    const int lo = args.ph_lo, hi = args.ph_hi;
    cg::grid_group grid = cg::this_grid();
    volatile LAS unsigned* MISC = (volatile LAS unsigned*)(lds + MISC_OFF);
    if (tid < 32) MISC[tid] = 0u;
    __syncthreads();
#define GRID_BAR() xcd_barrier(bar)
#define IN(k) (lo <= (k) && (k) < hi)
#define SEAM(k) do { if (IN(k) && IN((k) + 1)) GRID_BAR(); } while (0)

    if (bx == 0) { unsigned* bw = (unsigned*)(ws + WS_CTL) + 1024; for (int i = tid; i < XCD_BAR_WORDS; i += 512) bw[i] = 0u; }
    prologue(in, ws, lds, vcu, G, tid);
    grid.sync();
    XcdBarrier bar = xcd_barrier_post((unsigned*)(ws + WS_CTL) + 1024, MISC + 8);
    bf16_t* cur = (bf16_t*)(ws + WS_XA); bf16_t* alt = (bf16_t*)(ws + WS_XC);
    bf16_t* big = (bf16_t*)(ws + WS_BIG);
    float* ssx = (float*)(ws + WS_SSX); float* ssa = (float*)(ws + WS_SSA);
    bf16_t* w1t = (bf16_t*)(ws + WS_WMLP); bf16_t* w2t = w1t + (size_t)FF * DM;
    for (int L = 0; L < NLAYER; ++L) {
        const int base = 1 + L * PH_PER_LAYER, j = L >> 1; const bool mla = !(L & 1);
        int tl = tid; asm volatile("" : "+v"(tl));
        if (IN(base + 0)) {
            constexpr int NU_DOWN = (MT / 256) * (DOWNP / 256);
            { const bool idle_only = mla && G > NU_DOWN && !args.nogemm;
              const int cgw = (idle_only ? (bx - NU_DOWN) : vcu) * 8 + (tl >> 6), cngw = (idle_only ? (G - NU_DOWN) : G) * 8;
              if (!idle_only || bx >= NU_DOWN) {
                  convert_mlp(in, ws, L, (LAS float*)(lds + (tl >> 6) * 16384), cgw, cngw, tl & 63);
                  if (mla) convert_conv(in, ws, j, (LAS float*)(lds + (tl >> 6) * 16384), cgw, cngw, tl & 63);
              } }
            __syncthreads();
            if (!args.nogemm) {
                if (mla) {
                    pg8::Gemm g{cur, mla_w(ws, j).wd, MT, DOWNP, DM, DM, DM}; pg8::StaticOrder S; S.init(MT, DOWNP, G, bx);
                    int tpm = -1; { pg8::Unit u0; if (S.next(0, u0)) { tpm = u0.pm; pg8::fill_rstd_tab((LAS float*)(lds + RING_BYTES + 1024), ssx, 16, 4, 1.0f / DM, tpm, tl); } } __syncthreads();
                    pg8::EpiScale<0, 0, 1> E{alt, DOWNP, ssx, 16, 4, 1.0f / DM, ssa, (LAS float*)(lds + RING_BYTES + 1024), tpm};
                    if (DBG_ON(0)) pg8::gemm_phase<pg8::EpiScale<0, 0, 1>, pg8::StaticOrder, true>(lds, g, S, E);
                } else {
                    pg8::Gemm g{cur, conv_w(ws, j).win, MT, 3 * DM, DM, DM, DM}; pg8::StaticOrder S; S.init(MT, 3 * DM, G, bx);
                    int tpm = -1; { pg8::Unit u0; if (S.next(0, u0)) { tpm = u0.pm; pg8::fill_rstd_tab((LAS float*)(lds + RING_BYTES + 1024), ssx, 16, 4, 1.0f / DM, tpm, tl); } } __syncthreads();
                    pg8::EpiConvIn E{big, ssx, (LAS float*)(lds + RING_BYTES + 1024), tpm};
                    if (DBG_ON(1)) pg8::gemm_phase<pg8::EpiConvIn, pg8::StaticOrder, true>(lds, g, S, E);
                }
            }
        }
        if (mla) {
            bf16_t* qb = big; bf16_t* kb = big + (size_t)MT * QW; bf16_t* vt = kb + (size_t)MT * QW;
            SEAM(base + 0);
            if (IN(base + 1) && !args.nogemm) {
                const MlaW w = mla_w(ws, j);
                { pg8::Gemm g{alt, w.wuq, MT, QW, QLORA, DOWNP, QLORA}; pg8::StaticOrder S; S.init(MT, QW, G, bx);
                  pg8::EpiScale<0, 0, 0> E{qb, QW, ssa, 8, 1, 1.0f / QLORA, nullptr, nullptr, -1};
                  if (DBG_ON(2)) pg8::gemm_phase<pg8::EpiScale<0, 0, 0>, pg8::StaticOrder, true>(lds, g, S, E); }
                { pg8::Gemm g{alt + QLORA, w.wuk, MT, 1024, KVLORA, DOWNP, KVLORA}; pg8::StaticOrder S; S.init(MT, 1024, G, bx);
                  pg8::EpiScale<0, 1, 0> E{kb, QW, ssa + 4, 8, 1, 1.0f / KVLORA, nullptr, nullptr, -1};
                  if (DBG_ON(3)) pg8::gemm_phase<pg8::EpiScale<0, 1, 0>, pg8::StaticOrder, true>(lds, g, S, E);
                  if ((tl >> 6) == 0) __builtin_amdgcn_fence(__ATOMIC_ACQUIRE, "agent");
                  asm volatile("s_waitcnt vmcnt(0)" ::: "memory"); __syncthreads();
                  pg8::Unit u; for (int i = 0; S.next(i, u); ++i) knorm_unit(in.g_kn + j * DQK, in.g_qn + j * DQK, (const float*)(ws + WS_ROPE), kb, alt, u.pm, u.pn, tl); }
                { pg8::Gemm g{w.wuvt, alt + QLORA, 1024, MT, KVLORA, KVLORA, DOWNP}; pg8::StaticOrder S; S.init(1024, MT, G, bx);
                  pg8::EpiVT E{vt, MT, ssa};
                  if (DBG_ON(4)) pg8::gemm_phase<pg8::EpiVT, pg8::StaticOrder, true>(lds, g, S, E); }
            }
            SEAM(base + 1);
                        if (IN(base + 3) && !args.noattn) ATT_NS::attn_phase(lds, vcu, G, qb, kb, vt, alt, in.g_qn + j * DQK, (const float*)(ws + WS_ROPE));
            SEAM(base + 3);
            if (IN(base + 4) && !args.nogemm) {
                pg8::Gemm g{alt, mla_w(ws, j).wo, MT, DM, DM, DM, DM}; pg8::StaticOrder S; S.init(MT, DM, G, bx);
                pg8::EpiResid<false> E{cur, nullptr, ssx};
                if (DBG_ON(5)) pg8::gemm_phase<pg8::EpiResid<false>, pg8::StaticOrder, true>(lds, g, S, E);
            }
            SEAM(base + 4);
        } else {
            SEAM(base + 0);
            if (IN(base + 2)) conv_gate(in.c_w + (size_t)j * 3 * DM, big, alt, vcu, G, tl);
            if (IN(base + 2) && IN(base + 4)) GRID_BAR();
            if (IN(base + 4) && !args.nogemm) {
                pg8::Gemm g{alt, conv_w(ws, j).wout, MT, DM, DM, DM, DM}; pg8::StaticOrder S; S.init(MT, DM, G, bx);
                pg8::EpiResid<false> E{cur, nullptr, ssx};
                if (DBG_ON(6)) pg8::gemm_phase<pg8::EpiResid<false>, pg8::StaticOrder, true>(lds, g, S, E);
            }
            SEAM(base + 4);
        }
        if (IN(base + 5) && !args.nogemm) {
            pg8::Gemm g{cur, w1t, MT, FF, DM, DM, DM}; pg8::StaticOrder S; S.init(MT, FF, G, bx);
            int tpm = -1; { pg8::Unit u0; if (S.next(0, u0)) { tpm = u0.pm; pg8::fill_rstd_tab((LAS float*)(lds + RING_BYTES + 1024), ssx, 16, 4, 1.0f / DM, tpm, tl); } } __syncthreads();
            pg8::EpiScale<1, 0, 0> E{big, FF, ssx, 16, 4, 1.0f / DM, nullptr, (LAS float*)(lds + RING_BYTES + 1024), tpm};
            if (DBG_ON(7)) pg8::gemm_phase<pg8::EpiScale<1, 0, 0>, pg8::StaticOrder, false>(lds, g, S, E);
        }
        SEAM(base + 5);
        if (IN(base + 6) && !args.nogemm) {
            pg8::Gemm g{big, w2t, MT, DM, FF, FF, FF}; pg8::StaticOrder S; S.init(MT, DM, G, bx);
            if (L + 1 < NLAYER) { pg8::EpiResid<false> E{cur, nullptr, ssx};
                if (DBG_ON(8)) pg8::gemm_phase<pg8::EpiResid<false>, pg8::StaticOrder, true>(lds, g, S, E); }
            else { pg8::EpiResid<true> E{cur, args.out, ssx};
                if (DBG_ON(8)) pg8::gemm_phase<pg8::EpiResid<true>, pg8::StaticOrder, true>(lds, g, S, E); }
        }
        if (L + 1 < NLAYER) SEAM(base + 6);
    }
#undef IN
#undef SEAM
}

extern "C" void kernel_launch(void* const* d_in, const int* in_sizes, int n_in, void* d_out, int out_size, void* d_ws, size_t ws_size, hipStream_t stream) {
    static int grid = 0;
    if (grid == 0) {
        if (n_in != 17 || out_size != MT * DM || ws_size < WS_END) { fprintf(stderr, "kernel_launch: unexpected problem shape (n_in %d, out %d, ws %zu)\n", n_in, out_size, ws_size); grid = -1; return; }
        int dev = 0, cus = 0, per_cu = 0;
        hipGetDevice(&dev); hipDeviceGetAttribute(&cus, hipDeviceAttributeMultiprocessorCount, dev);
        if (hipFuncSetAttribute((const void*)mk_fwd, hipFuncAttributeMaxDynamicSharedMemorySize, LDS_BYTES) != hipSuccess) { fprintf(stderr, "kernel_launch: hipFuncSetAttribute failed\n"); grid = -1; return; }
        if (hipOccupancyMaxActiveBlocksPerMultiprocessor(&per_cu, (const void*)mk_fwd, 512, LDS_BYTES) != hipSuccess || per_cu < 1) { fprintf(stderr, "kernel_launch: occupancy query says %d\n", per_cu); per_cu = 1; }
        (void)hipGetLastError();
        grid = cus * per_cu;
    }
    if (grid < 0) return;
    Args a{};
    const void** ip = (const void**)&a.in;
    for (int i = 0; i < 17; ++i) ip[i] = d_in[i];
    a.out = (float*)d_out; a.ws = (unsigned char*)d_ws; a.nogemm = 0; a.noattn = 0;
    a.ph_lo = 0; a.ph_hi = NPH;
    void* kargs[] = {&a};
    hipError_t e = hipLaunchCooperativeKernel((const void*)mk_fwd, dim3(grid), dim3(512), kargs, LDS_BYTES, stream);
    if (e != hipSuccess) fprintf(stderr, "kernel_launch: cooperative launch failed: %s (grid %d)\n", hipGetErrorString(e), grid);
}
```

```cpp
#include <hip/hip_runtime.h>
#include <hip/hip_cooperative_groups.h>
#include <cstdio>
#include <cstdint>
namespace cg = cooperative_groups;

#ifndef DBG_MASK
#define DBG_MASK 0xffff
#endif
#define DBG_ON(k) ((DBG_MASK >> (k)) & 1)
#define ATT_NS att2

constexpr int NB = 2, SEQ = 8192, DM = 1024, MT = NB * SEQ, NH = 8, DQK = 192, DNOPE = 128, DROPE = 64, DV = 128;
constexpr int QLORA = 256, KVLORA = 128, DOWN = 448, DOWNP = 512, FF = 4096, NLAYER = 4;
constexpr int QW = NH * DQK;
constexpr float EPS = 1e-6f;
constexpr float QSCALE = 0.07216878364870322f * 1.4426950408889634f;

typedef unsigned short bf16_t;
typedef short bf16x8 __attribute__((ext_vector_type(8)));
typedef float f32x4 __attribute__((ext_vector_type(4)));
typedef float f32x16 __attribute__((ext_vector_type(16)));
typedef unsigned u32x4 __attribute__((ext_vector_type(4)));
typedef unsigned u32x2 __attribute__((ext_vector_type(2)));
#define LAS __attribute__((address_space(3)))

constexpr size_t MiB = 1u << 20;
constexpr size_t WS_CTL = 0;
constexpr size_t WS_SSX = 1 * MiB;
constexpr size_t WS_SSA = 2 * MiB;
constexpr size_t WS_ROPE = 3 * MiB;
constexpr size_t WS_WMIX = 8 * MiB;
constexpr size_t WMLA_BYTES = (size_t)(DOWNP * DM + QW * QLORA + 1024 * KVLORA + 1024 * KVLORA + DM * DM) * 2;
constexpr size_t WCONV_BYTES = (size_t)(3 * DM * DM + DM * DM) * 2;
constexpr size_t WS_WCONV = WS_WMIX + 2 * WMLA_BYTES;
constexpr size_t WS_WMLP = 34 * MiB;
constexpr size_t WS_XA = 52 * MiB, WS_XC = 84 * MiB;
constexpr size_t WS_BIG = 116 * MiB;
constexpr size_t WS_END = 244 * MiB;
static_assert(WS_WCONV + 2 * WCONV_BYTES <= WS_WMLP && WS_WMLP + 16 * MiB <= WS_XA, "ws map");

__device__ __forceinline__ unsigned f2bf(float f) { unsigned u = __builtin_bit_cast(unsigned, f); return (u + 0x7fffu + ((u >> 16) & 1u)) >> 16; }
__device__ __forceinline__ unsigned pk2(float lo, float hi) { return f2bf(lo) | (f2bf(hi) << 16); }
__device__ __forceinline__ float bf2f(bf16_t v) { return __builtin_bit_cast(float, (unsigned)v << 16); }
__device__ __forceinline__ float bflo(unsigned w) { return __builtin_bit_cast(float, w << 16); }
__device__ __forceinline__ float bfhi(unsigned w) { return __builtin_bit_cast(float, w & 0xffff0000u); }
__device__ __forceinline__ float wave_sum(float v) {
#pragma unroll
    for (int o = 1; o < 64; o <<= 1) v += __shfl_xor(v, o);
    return v;
}
__device__ __forceinline__ float wave_max(float v) {
#pragma unroll
    for (int o = 1; o < 64; o <<= 1) v = fmaxf(v, __shfl_xor(v, o));
    return v;
}
__device__ __forceinline__ float rstd_from(const float* ssp, int n4, float inv_dim) {
    float s = 0.f;
    for (int i = 0; i < n4; ++i) { const f32x4 v = ((const f32x4*)ssp)[i]; s += (v.x + v.y) + (v.z + v.w); }
    return rsqrtf(s * inv_dim + EPS);
}

namespace pg8 {
constexpr int BM = 256, BK = 64, HALF = 128, HTB = HALF * BK * 2, STAGE_BYTES = 8 * HTB, NXCD = 8, WGM = 8;
__host__ __device__ __forceinline__ int lds_byte(int r, int c) { const int st = (r >> 4) * 2 + (c >> 5), rr = r & 15, cc = c & 31, ob = rr * 64 + cc * 2; return st * 1024 + (ob ^ (((ob >> 9) & 1) << 5)); }
__host__ __device__ __forceinline__ void stage_rc(int b, int& R, int& C) { const int st = b / 1024, sb = b % 1024, swz = sb ^ (((sb >> 9) & 1) << 5); R = (st >> 1) * 16 + swz / 64; C = (st & 1) * 32 + (swz % 64) / 2; }
__host__ __device__ __forceinline__ int perm32(int rho) { const int n = rho >> 4, i = rho & 15; return 8 * (i >> 2) + 4 * n + (i & 3); }

struct Unit { int pm, pn; };
struct Gemm { const bf16_t* A; const bf16_t* Bt; int M, N, K, lda, ldb; };

struct StaticOrder {
    int nM, nN, nwg, G, c;
    __host__ __device__ void init(int M, int N, int G_, int c_) { nM = M / BM; nN = N / BM; nwg = nM * nN; G = G_; c = c_; }
    __host__ __device__ bool next(int i, Unit& u) const {
        const long L = (long)i * G + c; if (L >= nwg) return false;
        int wgid = (int)L; { const int q = nwg / NXCD, r = nwg % NXCD, xcd = wgid % NXCD, off = wgid / NXCD; wgid = (xcd < r ? xcd * (q + 1) : r * (q + 1) + (xcd - r) * q) + off; }
        const int nig = WGM * nN, gid = wgid / nig, fm = gid * WGM, gsz = (nM - fm) < WGM ? (nM - fm) : WGM;
        u.pm = fm + ((wgid % nig) % gsz); u.pn = (wgid % nig) / gsz; return true;
    }
};

__device__ __forceinline__ unsigned cvt_pk_bf16(float lo, float hi) { unsigned r; asm volatile("v_cvt_pk_bf16_f32 %0, %1, %2" : "=v"(r) : "v"(lo), "v"(hi)); return r; }

template <int ACT  , int REMAP  , int SSMODE> struct EpiScale {
    static constexpr bool PERM = true;
    bf16_t* O; int ldc; const float* ssp; int ss_stride, ss_n4; float inv_dim; float* ss_out;
    const LAS float* tab; int tab_pm;
    __device__ __forceinline__ void operator()(const f32x4 (&acc)[2][2][4][2], const Unit& u, int wr, int wc, int fr, int fq) const {
        const int row0 = u.pm * BM + wr * 64 + fr, colt = u.pn * BM + wc * 32 + 8 * fq;
        float rsv[2][4];
#pragma unroll
        for (int ai = 0; ai < 2; ++ai)
#pragma unroll
            for (int m = 0; m < 4; ++m) rsv[ai][m] = (u.pm == tab_pm) ? tab[wr * 64 + fr + ai * HALF + m * 16] : rstd_from(ssp + (size_t)(row0 + ai * HALF + m * 16) * ss_stride, ss_n4, inv_dim);
#pragma unroll
        for (int ai = 0; ai < 2; ++ai)
#pragma unroll
            for (int m = 0; m < 4; ++m) {
                const int row = row0 + ai * HALF + m * 16;
                const float rs = rsv[ai][m];
                float ssq = 0.f;
#pragma unroll
                for (int bj = 0; bj < 2; ++bj) {
                    const int col = colt + bj * HALF, dcol = REMAP ? ((col >> 7) * 192 + (col & 127)) : col;
                    f32x4 v0 = acc[ai][bj][m][0] * rs, v1 = acc[ai][bj][m][1] * rs;
                    if (SSMODE == 1) { if (u.pn == 0 || bj == 0) ssq += (v0.x * v0.x + v0.y * v0.y) + (v0.z * v0.z + v0.w * v0.w) + (v1.x * v1.x + v1.y * v1.y) + (v1.z * v1.z + v1.w * v1.w); }
                    if (ACT == 1) {
                        v0.x = fmaxf(v0.x, 0.f); v0.y = fmaxf(v0.y, 0.f); v0.z = fmaxf(v0.z, 0.f); v0.w = fmaxf(v0.w, 0.f);
                        v1.x = fmaxf(v1.x, 0.f); v1.y = fmaxf(v1.y, 0.f); v1.z = fmaxf(v1.z, 0.f); v1.w = fmaxf(v1.w, 0.f);
                        v0 = v0 * v0; v1 = v1 * v1; }
                    u32x4 w; w.x = cvt_pk_bf16(v0.x, v0.y); w.y = cvt_pk_bf16(v0.z, v0.w); w.z = cvt_pk_bf16(v1.x, v1.y); w.w = cvt_pk_bf16(v1.z, v1.w);
                    *(u32x4*)(O + (size_t)row * ldc + dcol) = w;
                }
                if (SSMODE == 1) { ssq += __shfl_xor(ssq, 16); ssq += __shfl_xor(ssq, 32); if (fq == 0 && u.pn < 2) ss_out[(size_t)row * 8 + u.pn * 4 + wc] = ssq; }
            }
    }
};
struct EpiConvIn {
    static constexpr bool PERM = true;
    bf16_t* O; const float* ssp; const LAS float* tab; int tab_pm;
    __device__ __forceinline__ void operator()(const f32x4 (&acc)[2][2][4][2], const Unit& u, int wr, int wc, int fr, int fq) const {
        const int row0 = u.pm * BM + wr * 64 + fr, cl = wc * 32 + 8 * fq;
        float rsv[2][4];
#pragma unroll
        for (int ai = 0; ai < 2; ++ai)
#pragma unroll
            for (int m = 0; m < 4; ++m) rsv[ai][m] = (u.pm == tab_pm) ? tab[wr * 64 + fr + ai * HALF + m * 16] : rstd_from(ssp + (size_t)(row0 + ai * HALF + m * 16) * 16, 4, 1.0f / DM);
#pragma unroll
        for (int ai = 0; ai < 2; ++ai)
#pragma unroll
            for (int m = 0; m < 4; ++m) {
                const int row = row0 + ai * HALF + m * 16; const float rs = rsv[ai][m];
                bf16_t* orow = O + (size_t)row * (2 * DM);
                if (u.pn < 4) {
#pragma unroll
                    for (int bj = 0; bj < 2; ++bj) { const f32x4 v0 = acc[ai][bj][m][0] * rs, v1 = acc[ai][bj][m][1] * rs;
                        u32x4 w; w.x = cvt_pk_bf16(v0.x, v0.y); w.y = cvt_pk_bf16(v0.z, v0.w); w.z = cvt_pk_bf16(v1.x, v1.y); w.w = cvt_pk_bf16(v1.z, v1.w);
                        *(u32x4*)(orow + u.pn * BM + bj * HALF + cl) = w; }
                } else {
                    const float r2 = rs * rs;
                    const f32x4 v0 = acc[ai][0][m][0] * acc[ai][1][m][0] * r2, v1 = acc[ai][0][m][1] * acc[ai][1][m][1] * r2;
                    u32x4 w; w.x = cvt_pk_bf16(v0.x, v0.y); w.y = cvt_pk_bf16(v0.z, v0.w); w.z = cvt_pk_bf16(v1.x, v1.y); w.w = cvt_pk_bf16(v1.z, v1.w);
                    *(u32x4*)(orow + DM + (u.pn - 4) * HALF + cl) = w;
                }
            }
    }
};
__device__ __forceinline__ void fill_rstd_tab(LAS float* tab, const float* ssp, int ss_stride, int ss_n4, float inv_dim, int pm, int tid) {
    if (tid < 256) tab[tid] = rstd_from(ssp + (size_t)(pm * BM + tid) * ss_stride, ss_n4, inv_dim);
}
struct EpiVT {
    static constexpr bool PERM = true;
    bf16_t* O; int ldc; const float* ssa;
    __device__ __forceinline__ void operator()(const f32x4 (&acc)[2][2][4][2], const Unit& u, int wr, int wc, int fr, int fq) const {
        const int row0 = u.pm * BM + wr * 64 + fr, colt = u.pn * BM + wc * 32 + 8 * fq;
#pragma unroll
        for (int bj = 0; bj < 2; ++bj) {
            float cs[8];
#pragma unroll
            for (int j = 0; j < 8; ++j) cs[j] = rstd_from(ssa + (size_t)(colt + bj * HALF + j) * 8 + 4, 1, 1.0f / KVLORA);
#pragma unroll
            for (int ai = 0; ai < 2; ++ai)
#pragma unroll
                for (int m = 0; m < 4; ++m) {
                    const int row = row0 + ai * HALF + m * 16;
                    const f32x4 a0 = acc[ai][bj][m][0], a1 = acc[ai][bj][m][1];
                    u32x4 w; w.x = cvt_pk_bf16(a0.x * cs[0], a0.y * cs[1]); w.y = cvt_pk_bf16(a0.z * cs[2], a0.w * cs[3]);
                    w.z = cvt_pk_bf16(a1.x * cs[4], a1.y * cs[5]); w.w = cvt_pk_bf16(a1.z * cs[6], a1.w * cs[7]);
                    *(u32x4*)(O + (size_t)row * ldc + colt + bj * HALF) = w;
                }
            asm volatile("" ::: "memory");
        }
    }
};
template <bool FINAL> struct EpiResid {
    static constexpr bool PERM = true;
    bf16_t* xb; float* xout; float* ssx;
    __device__ __forceinline__ void operator()(const f32x4 (&acc)[2][2][4][2], const Unit& u, int wr, int wc, int fr, int fq) const {
        const int row0 = u.pm * BM + wr * 64 + fr, colt = u.pn * BM + wc * 32 + 8 * fq;
#pragma unroll
        for (int ai = 0; ai < 2; ++ai) {
            u32x4 xv[4][2];
#pragma unroll
            for (int m = 0; m < 4; ++m)
#pragma unroll
                for (int bj = 0; bj < 2; ++bj) xv[m][bj] = *(const u32x4*)(xb + (size_t)(row0 + ai * HALF + m * 16) * DM + colt + bj * HALF);
            asm volatile("" ::: "memory");
#pragma unroll
            for (int m = 0; m < 4; ++m) {
                const int row = row0 + ai * HALF + m * 16; float ssq = 0.f;
#pragma unroll
                for (int bj = 0; bj < 2; ++bj) {
                    const size_t off = (size_t)row * DM + colt + bj * HALF;
                    const u32x4 xw = xv[m][bj];
                    f32x4 v0 = acc[ai][bj][m][0], v1 = acc[ai][bj][m][1];
                    v0.x += bflo(xw.x); v0.y += bfhi(xw.x); v0.z += bflo(xw.y); v0.w += bfhi(xw.y);
                    v1.x += bflo(xw.z); v1.y += bfhi(xw.z); v1.z += bflo(xw.w); v1.w += bfhi(xw.w);
                    if (FINAL) { *(f32x4*)(xout + off) = v0; *(f32x4*)(xout + off + 4) = v1; }
                    else {
                        ssq += (v0.x * v0.x + v0.y * v0.y) + (v0.z * v0.z + v0.w * v0.w) + (v1.x * v1.x + v1.y * v1.y) + (v1.z * v1.z + v1.w * v1.w);
                        u32x4 w; w.x = cvt_pk_bf16(v0.x, v0.y); w.y = cvt_pk_bf16(v0.z, v0.w); w.z = cvt_pk_bf16(v1.x, v1.y); w.w = cvt_pk_bf16(v1.z, v1.w);
                        *(u32x4*)(xb + off) = w;
                    }
                }
                if (!FINAL) { ssq += __shfl_xor(ssq, 16); ssq += __shfl_xor(ssq, 32); if (fq == 0) ssx[(size_t)row * 16 + u.pn * 4 + wc] = ssq; }
            }
            asm volatile("" ::: "memory");
        }
    }
};

template <class Epi, class Sched, bool ALIGN_EPI>
__device__ __forceinline__ void gemm_phase(LAS unsigned char* lds, const Gemm g, const Sched& S, const Epi& E) {
    int tid = threadIdx.x; asm volatile("" : "+v"(tid));
    const int wid = __builtin_amdgcn_readfirstlane(tid >> 6), lane = tid & 63, wr = wid >> 2, wc = wid & 3, fr = lane & 15, fq = lane >> 4;
    int K = g.K; asm volatile("" : "+s"(K));
    const int nt = K / BK;
    unsigned voffA[2], voffB[2];
#pragma unroll
    for (int i = 0; i < 2; ++i) { int R, C; stage_rc(tid * 16 + i * 8192, R, C); const int Rb = Epi::PERM ? ((R & ~31) + perm32(R & 31)) : R;
        voffA[i] = (unsigned)(R * g.lda + C) * 2u; voffB[i] = (unsigned)(Rb * g.ldb + C) * 2u; }
    const size_t kstep = (size_t)(BK * 2);
    const size_t hstepA = (size_t)HALF * g.lda * 2, hstepB = (size_t)HALF * g.ldb * 2;
    const size_t tstepA = 2 * hstepA, tstepB = 2 * hstepB;
    const unsigned ldsw = (unsigned)wid * 1024u;
    const int aoff = lds_byte(wr * 64 + fr, fq * 8), boff = lds_byte(wc * 32 + fr, fq * 8);
#define PG8_SA(b, h) (((b) * 2 + (h)) * HTB)
#define PG8_SB(b, h) ((4 + (b) * 2 + (h)) * HTB)
#define PG8_STAGE(bufoff, gbase, voff) do { _Pragma("unroll") for (int _i = 0; _i < 2; ++_i) \
        __builtin_amdgcn_global_load_lds((const unsigned*)((const char*)(gbase) + (voff)[_i]), (LAS unsigned*)(lds + (bufoff) + ldsw + _i * 8192), 16, 0, 0); } while (0)
#define PG8_LDA(dst, b, h) do { _Pragma("unroll") for (int m = 0; m < 4; ++m) _Pragma("unroll") for (int k = 0; k < 2; ++k) dst[m][k] = *(const LAS bf16x8*)(lds + PG8_SA(b, h) + aoff + m * 2048 + k * 1024); } while (0)
#define PG8_LDB(dst, b, h) do { _Pragma("unroll") for (int n = 0; n < 2; ++n) _Pragma("unroll") for (int k = 0; k < 2; ++k) dst[n][k] = *(const LAS bf16x8*)(lds + PG8_SB(b, h) + boff + n * 2048 + k * 1024); } while (0)
#define PG8_MMA(ai, bj, At, Bt) do { __builtin_amdgcn_s_setprio(1); _Pragma("unroll") for (int m = 0; m < 4; ++m) _Pragma("unroll") for (int n = 0; n < 2; ++n) _Pragma("unroll") for (int k = 0; k < 2; ++k) \
        acc[ai][bj][m][n] = __builtin_amdgcn_mfma_f32_16x16x32_bf16(Bt[n][k], At[m][k], acc[ai][bj][m][n], 0, 0, 0); __builtin_amdgcn_s_setprio(0); } while (0)
#define PG8_WAIT_V(n) asm volatile("s_waitcnt vmcnt(" #n ")" ::: "memory")
#define PG8_WAIT_L(n) asm volatile("s_waitcnt lgkmcnt(" #n ")" ::: "memory")
#define PG8_BAR __builtin_amdgcn_s_barrier()
#define PG8_SCHED __builtin_amdgcn_sched_barrier(0)
    Unit cur, nxt; int ui = 0;
    if (!S.next(0, cur)) return;
    f32x4 acc[2][2][4][2];
#pragma unroll
    for (int a = 0; a < 2; ++a)
#pragma unroll
        for (int b = 0; b < 2; ++b)
#pragma unroll
            for (int m = 0; m < 4; ++m)
#pragma unroll
                for (int n = 0; n < 2; ++n) acc[a][b][m][n] = (f32x4){0.f, 0.f, 0.f, 0.f};
    bf16x8 At[4][2], B0[2][2], B1[2][2];
    const char* cA = (const char*)g.A + (size_t)cur.pm * tstepA; const char* cB = (const char*)g.Bt + (size_t)cur.pn * tstepB;
    PG8_STAGE(PG8_SB(0, 0), cB, voffB); PG8_STAGE(PG8_SB(0, 1), cB + hstepB, voffB); PG8_STAGE(PG8_SA(0, 0), cA, voffA); PG8_STAGE(PG8_SA(0, 1), cA + hstepA, voffA);
    if (wr == 1) PG8_BAR;
    PG8_WAIT_V(2); PG8_BAR;
    PG8_STAGE(PG8_SB(1, 0), cB + kstep, voffB); PG8_STAGE(PG8_SA(1, 0), cA + kstep, voffA); PG8_STAGE(PG8_SB(1, 1), cB + hstepB + kstep, voffB);
    PG8_WAIT_V(6); PG8_BAR;
    for (;;) {
        const bool has_next = S.next(ui + 1, nxt);
        const char* nA = has_next ? (const char*)g.A + (size_t)nxt.pm * tstepA : cA; const char* nB = has_next ? (const char*)g.Bt + (size_t)nxt.pn * tstepB : cB;
        for (int t = 0; t < nt; t += 2) {
            const bool last = (t == nt - 2);
            const char* a1 = cA + (size_t)(t + 1) * kstep;
            const char* a2 = last ? nA : cA + (size_t)(t + 2) * kstep; const char* b2 = last ? nB : cB + (size_t)(t + 2) * kstep;
            const char* a3 = a2 + kstep; const char* b3 = b2 + kstep;
            PG8_LDB(B0, 0, 0); PG8_LDB(B1, 0, 1); PG8_SCHED; PG8_LDA(At, 0, 0); PG8_STAGE(PG8_SA(1, 1), a1 + hstepA, voffA);
            PG8_WAIT_V(8); PG8_WAIT_L(0); PG8_BAR; PG8_MMA(0, 0, At, B0); PG8_MMA(0, 1, At, B1); PG8_BAR; PG8_SCHED;
            PG8_LDA(At, 0, 1); PG8_STAGE(PG8_SB(0, 0), b2, voffB); PG8_STAGE(PG8_SB(0, 1), b2 + hstepB, voffB); PG8_STAGE(PG8_SA(0, 0), a2, voffA);
            PG8_WAIT_V(8); PG8_WAIT_L(0); PG8_BAR; PG8_MMA(1, 0, At, B0); PG8_MMA(1, 1, At, B1); PG8_BAR; PG8_SCHED;
            PG8_LDB(B0, 1, 0); PG8_LDB(B1, 1, 1); PG8_SCHED; PG8_LDA(At, 1, 0); PG8_STAGE(PG8_SA(0, 1), a2 + hstepA, voffA);
            PG8_WAIT_V(8); PG8_WAIT_L(0); PG8_BAR; PG8_MMA(0, 0, At, B0); PG8_MMA(0, 1, At, B1); PG8_BAR; PG8_SCHED;
            PG8_LDA(At, 1, 1); PG8_STAGE(PG8_SB(1, 0), b3, voffB); PG8_STAGE(PG8_SB(1, 1), b3 + hstepB, voffB); PG8_STAGE(PG8_SA(1, 0), a3, voffA);
            PG8_WAIT_V(8); PG8_WAIT_L(0); PG8_BAR; PG8_MMA(1, 0, At, B0); PG8_MMA(1, 1, At, B1); PG8_BAR; PG8_SCHED;
        }
        if constexpr (ALIGN_EPI) { if (wr == 0) PG8_BAR; }
        E(acc, cur, wr, wc, fr, fq);
        if (!has_next) break;
#pragma unroll
        for (int a = 0; a < 2; ++a)
#pragma unroll
            for (int b = 0; b < 2; ++b)
#pragma unroll
                for (int m = 0; m < 4; ++m)
#pragma unroll
                    for (int n = 0; n < 2; ++n) acc[a][b][m][n] = (f32x4){0.f, 0.f, 0.f, 0.f};
        cur = nxt; cA = nA; cB = nB; ++ui;
        if constexpr (ALIGN_EPI) { if (wr == 1) PG8_BAR; }
    }
    PG8_WAIT_V(0);
    if constexpr (!ALIGN_EPI) { if (wr == 0) PG8_BAR; }
    PG8_BAR;
#undef PG8_SA
#undef PG8_SB
#undef PG8_STAGE
#undef PG8_LDA
#undef PG8_LDB
#undef PG8_MMA
#undef PG8_WAIT_V
#undef PG8_WAIT_L
#undef PG8_BAR
#undef PG8_SCHED
}
}

namespace att2 {
constexpr int KBUF = 64 * 384, VBUF = 128 * 128;
constexpr int L_K = 0, L_V = 2 * KBUF, L_WS = L_V + 2 * VBUF, L_END = L_WS + 8 * 128;
constexpr float THR = 8.0f;
typedef float f32x2_t __attribute__((ext_vector_type(2))); typedef __bf16 bf16x2_t __attribute__((ext_vector_type(2)));
__device__ __forceinline__ unsigned cvtpk(float lo, float hi) { f32x2_t v = {lo, hi}; bf16x2_t b = __builtin_convertvector(v, bf16x2_t); return __builtin_bit_cast(unsigned, b); }
__device__ __forceinline__ int kperm(int r) { return (r & ~12) | ((r & 4) << 1) | ((r & 8) >> 1); }
#define SGB(m, n) __builtin_amdgcn_sched_group_barrier(m, n, 0)
__device__ __forceinline__ float rowmax32(const f32x16& a, const f32x16& b) {
    float x = __builtin_fmaxf(__builtin_fmaxf(a[0], a[1]), b[0]), y = __builtin_fmaxf(__builtin_fmaxf(a[2], a[3]), b[1]);
    x = __builtin_fmaxf(__builtin_fmaxf(x, b[2]), b[3]);
#pragma unroll
    for (int r = 4; r < 16; r += 4) { x = __builtin_fmaxf(__builtin_fmaxf(x, a[r]), a[r + 1]); y = __builtin_fmaxf(__builtin_fmaxf(y, a[r + 2]), a[r + 3]);
        x = __builtin_fmaxf(__builtin_fmaxf(x, b[r]), b[r + 1]); y = __builtin_fmaxf(__builtin_fmaxf(y, b[r + 2]), b[r + 3]); }
    return __builtin_fmaxf(x, y);
}
__device__ __forceinline__ float xhalf_max(float m) { auto rr = __builtin_amdgcn_permlane32_swap(__float_as_uint(m), __float_as_uint(m), false, false); return __builtin_fmaxf(__uint_as_float(rr[0]), __uint_as_float(rr[1])); }

__device__ __forceinline__ void attn_unit(LAS unsigned char* lds, int b, int h, int qb, const bf16_t* __restrict__ Q, const bf16_t* __restrict__ Kg, const bf16_t* __restrict__ VT, bf16_t* __restrict__ O, const float* __restrict__ gq, const float* __restrict__ rope) {
    int tid = threadIdx.x; asm volatile("" : "+v"(tid));
    const int lane = tid & 63, r32 = lane & 31, hh = lane >> 5; const int wid = __builtin_amdgcn_readfirstlane(tid >> 6);
    const int q0 = qb * 256, q0w = q0 + wid * 32;
    const size_t tokb = (size_t)b * SEQ;
    const int NT = (q0 + 256) / 64;
    const int my_last = (q0w + 31) / 64;
    unsigned kgo[3], vgo[2];
#pragma unroll
    for (int i = 0; i < 3; ++i) { const int slot = (wid * 3 + i) * 64 + lane, row = slot / 24, cc = slot % 24, c = (cc & ~7) | ((cc & 7) ^ ((row >> 1) & 7)); kgo[i] = (unsigned)(row * QW + c * 8) * 2u; }
#pragma unroll
    for (int i = 0; i < 2; ++i) { const int slot = (wid * 2 + i) * 64 + lane, d = slot >> 3, cc = slot & 7, c = cc ^ ((d >> 1) & 7); vgo[i] = (unsigned)(d * MT + c * 8) * 2u; }
    const char* kbase = (const char*)(Kg + tokb * QW + h * DQK);
    const char* vbase = (const char*)(VT + (size_t)(h * DV) * MT + tokb);
#define A2_DMA_K(t, buf) do { _Pragma("unroll") for (int i = 0; i < 3; ++i) __builtin_amdgcn_global_load_lds((const unsigned*)(kbase + (size_t)(t) * (64 * QW * 2) + kgo[i]), \
        (LAS unsigned*)(lds + L_K + (buf) * KBUF + (wid * 3 + i) * 1024), 16, 0, 0); } while (0)
#define A2_DMA_V(t, buf) do { _Pragma("unroll") for (int i = 0; i < 2; ++i) __builtin_amdgcn_global_load_lds((const unsigned*)(vbase + (size_t)(t) * 128 + vgo[i]), \
        (LAS unsigned*)(lds + L_V + (buf) * VBUF + (wid * 2 + i) * 1024), 16, 0, 0); } while (0)
    A2_DMA_K(0, 0); A2_DMA_V(0, 0); if (NT > 1) A2_DMA_K(1, 1);
    bf16x8 qf[12];
    { const bf16_t* qp = Q + (tokb + q0w + r32) * QW + h * DQK + hh * 8;
#pragma unroll
      for (int st = 0; st < 12; ++st) qf[st] = *(const bf16x8*)(qp + st * 16);
      float ss = 0.f;
#pragma unroll
      for (int st = 0; st < 12; ++st) { const u32x4 w = __builtin_bit_cast(u32x4, qf[st]);
          ss += bflo(w.x) * bflo(w.x) + bfhi(w.x) * bfhi(w.x) + bflo(w.y) * bflo(w.y) + bfhi(w.y) * bfhi(w.y) + bflo(w.z) * bflo(w.z) + bfhi(w.z) * bfhi(w.z) + bflo(w.w) * bflo(w.w) + bfhi(w.w) * bfhi(w.w); }
      { auto rr = __builtin_amdgcn_permlane32_swap(__float_as_uint(ss), __float_as_uint(ss), false, false); ss = __uint_as_float(rr[0]) + __uint_as_float(rr[1]); }
      const float rs = rsqrtf(ss * (1.0f / DQK) + EPS) * QSCALE;
      const float* gp = gq + 8 * hh;
      const float* rp = rope + (tokb + q0w + r32) * 64 + 8 * hh;
#pragma unroll
      for (int st = 0; st < 8; ++st) { const u32x4 w = __builtin_bit_cast(u32x4, qf[st]);
          u32x4 o; o.x = cvtpk(bflo(w.x) * rs, bfhi(w.x) * rs); o.y = cvtpk(bflo(w.y) * rs, bfhi(w.y) * rs);
          o.z = cvtpk(bflo(w.z) * rs, bfhi(w.z) * rs); o.w = cvtpk(bflo(w.w) * rs, bfhi(w.w) * rs);
          qf[st] = __builtin_bit_cast(bf16x8, o); }
#pragma unroll
      for (int st = 8; st < 10; ++st) {
          const u32x4 w1 = __builtin_bit_cast(u32x4, qf[st]), w2 = __builtin_bit_cast(u32x4, qf[st + 2]);
          const f32x4 ga0 = *(const f32x4*)(gp + 16 * st), ga1 = *(const f32x4*)(gp + 16 * st + 4), gb0 = *(const f32x4*)(gp + 16 * st + 32), gb1 = *(const f32x4*)(gp + 16 * st + 36);
          const f32x4 c0 = *(const f32x4*)(rp + 16 * (st - 8)), c1 = *(const f32x4*)(rp + 16 * (st - 8) + 4), s0 = *(const f32x4*)(rp + 32 + 16 * (st - 8)), s1 = *(const f32x4*)(rp + 32 + 16 * (st - 8) + 4);
          float x1[8], x2[8], cs[8], sn[8];
          x1[0] = bflo(w1.x) * rs * ga0.x; x1[1] = bfhi(w1.x) * rs * ga0.y; x1[2] = bflo(w1.y) * rs * ga0.z; x1[3] = bfhi(w1.y) * rs * ga0.w;
          x1[4] = bflo(w1.z) * rs * ga1.x; x1[5] = bfhi(w1.z) * rs * ga1.y; x1[6] = bflo(w1.w) * rs * ga1.z; x1[7] = bfhi(w1.w) * rs * ga1.w;
          x2[0] = bflo(w2.x) * rs * gb0.x; x2[1] = bfhi(w2.x) * rs * gb0.y; x2[2] = bflo(w2.y) * rs * gb0.z; x2[3] = bfhi(w2.y) * rs * gb0.w;
          x2[4] = bflo(w2.z) * rs * gb1.x; x2[5] = bfhi(w2.z) * rs * gb1.y; x2[6] = bflo(w2.w) * rs * gb1.z; x2[7] = bfhi(w2.w) * rs * gb1.w;
          cs[0] = c0.x; cs[1] = c0.y; cs[2] = c0.z; cs[3] = c0.w; cs[4] = c1.x; cs[5] = c1.y; cs[6] = c1.z; cs[7] = c1.w;
          sn[0] = s0.x; sn[1] = s0.y; sn[2] = s0.z; sn[3] = s0.w; sn[4] = s1.x; sn[5] = s1.y; sn[6] = s1.z; sn[7] = s1.w;
          float y1[8], y2[8];
#pragma unroll
          for (int i = 0; i < 8; ++i) { y1[i] = x1[i] * cs[i] - x2[i] * sn[i]; y2[i] = x2[i] * cs[i] + x1[i] * sn[i]; }
          u32x4 o1, o2; o1.x = cvtpk(y1[0], y1[1]); o1.y = cvtpk(y1[2], y1[3]); o1.z = cvtpk(y1[4], y1[5]); o1.w = cvtpk(y1[6], y1[7]);
          o2.x = cvtpk(y2[0], y2[1]); o2.y = cvtpk(y2[2], y2[3]); o2.z = cvtpk(y2[4], y2[5]); o2.w = cvtpk(y2[6], y2[7]);
          qf[st] = __builtin_bit_cast(bf16x8, o1); qf[st + 2] = __builtin_bit_cast(bf16x8, o2); }
    }
    __builtin_amdgcn_sched_barrier(0);
    int ka[4], va[4];
    { const int row = kperm(r32), g = (row >> 1) & 7;
#pragma unroll
      for (int j = 0; j < 4; ++j) ka[j] = L_K + row * 384 + (((2 * j + hh) ^ g) * 16);
      const int gv = (r32 >> 1) & 7;
#pragma unroll
      for (int sI = 0; sI < 4; ++sI) va[sI] = L_V + r32 * 128 + (((2 * sI + hh) ^ gv) * 16); }
#define A2_KF(buf, st, half) (*(const LAS bf16x8*)(lds + ka[(st) & 3] + (buf) * KBUF + ((st) >> 2) * 128 + (half) * (32 * 384)))
#define A2_VF(buf, db, sI) (*(const LAS bf16x8*)(lds + va[sI] + (buf) * VBUF + (db) * (32 * 128)))
    f32x16 o[4];
#pragma unroll
    for (int d = 0; d < 4; ++d)
#pragma unroll
        for (int r = 0; r < 16; ++r) o[d][r] = 0.f;
    float m_run = 0.f, l_run = 0.f;
    f32x16 negm;
#pragma unroll
    for (int r = 0; r < 16; ++r) negm[r] = 0.f;
    LAS float* wsf = (LAS float*)(lds + L_WS + wid * 128);
    asm volatile("s_waitcnt vmcnt(0)" ::: "memory");
    __syncthreads();
    if (wid >= 4) __builtin_amdgcn_s_setprio(1);
    f32x16 s0, s1;
    { s0 = negm; s1 = negm;
#pragma unroll
      for (int st = 0; st < 12; ++st) { s0 = __builtin_amdgcn_mfma_f32_32x32x16_bf16(A2_KF(0, st, 0), qf[st], s0, 0, 0, 0); s1 = __builtin_amdgcn_mfma_f32_32x32x16_bf16(A2_KF(0, st, 1), qf[st], s1, 0, 0, 0); }
      if (63 > q0w) { const int qi = q0w + r32, kv0 = 8 * hh;
#pragma unroll
          for (int r = 0; r < 16; ++r) { const int kv = kv0 + (r & 7) + 16 * (r >> 3); if (kv > qi) s0[r] = -1e30f; if (kv + 32 > qi) s1[r] = -1e30f; } }
      const float rm = xhalf_max(rowmax32(s0, s1));
      m_run = rm;
#pragma unroll
      for (int r = 0; r < 16; ++r) { s0[r] -= rm; s1[r] -= rm; negm[r] = -rm; }
    }
    asm volatile("s_waitcnt lgkmcnt(0)" ::: "memory");
    __builtin_amdgcn_s_barrier();
    asm volatile("" ::: "memory");
    for (int t = 0; t < NT; ++t) {
        const int cb = t & 1, nb = cb ^ 1;
        if (t + 2 < NT) A2_DMA_K(t + 2, cb);
        if (t + 1 < NT) A2_DMA_V(t + 1, nb);
        if (t <= my_last) {
            const bool has_next = (t + 1 <= my_last);
            f32x16 n0 = negm, n1 = negm;
            bf16x8 pf[4];
            float ls = 0.f;
            if (has_next) {
#pragma unroll
                for (int st = 0; st < 12; ++st) { n0 = __builtin_amdgcn_mfma_f32_32x32x16_bf16(A2_KF(nb, st, 0), qf[st], n0, 0, 0, 0); n1 = __builtin_amdgcn_mfma_f32_32x32x16_bf16(A2_KF(nb, st, 1), qf[st], n1, 0, 0, 0); }
            }
#pragma unroll
            for (int r = 0; r < 16; ++r) { s0[r] = __builtin_amdgcn_exp2f(s0[r]); s1[r] = __builtin_amdgcn_exp2f(s1[r]); }
#pragma unroll
            for (int r = 0; r < 16; ++r) ls += s0[r] + s1[r];
#pragma unroll
            for (int sI = 0; sI < 4; ++sI) { u32x4 w;
                if (sI < 2) { w.x = cvtpk(s0[8 * sI + 0], s0[8 * sI + 1]); w.y = cvtpk(s0[8 * sI + 2], s0[8 * sI + 3]); w.z = cvtpk(s0[8 * sI + 4], s0[8 * sI + 5]); w.w = cvtpk(s0[8 * sI + 6], s0[8 * sI + 7]); }
                else { const int s2 = sI - 2; w.x = cvtpk(s1[8 * s2 + 0], s1[8 * s2 + 1]); w.y = cvtpk(s1[8 * s2 + 2], s1[8 * s2 + 3]); w.z = cvtpk(s1[8 * s2 + 4], s1[8 * s2 + 5]); w.w = cvtpk(s1[8 * s2 + 6], s1[8 * s2 + 7]); }
                pf[sI] = __builtin_bit_cast(bf16x8, w); }
            l_run += ls;
            if (has_next) {
                SGB(0x100, 4);
#pragma unroll
                for (int i = 0; i < 20; ++i) { SGB(0x008, 1); SGB(0x100, 1); SGB(0x002, 4); }
#pragma unroll
                for (int i = 0; i < 4; ++i) { SGB(0x008, 1); SGB(0x002, 4); }
                __builtin_amdgcn_sched_barrier(0);
                if ((t + 1) * 64 + 63 > q0w) { const int qi = q0w + r32, kv0 = (t + 1) * 64 + 8 * hh;
#pragma unroll
                    for (int r = 0; r < 16; ++r) { const int kv = kv0 + (r & 7) + 16 * (r >> 3); if (kv > qi) n0[r] = -1e30f; if (kv + 32 > qi) n1[r] = -1e30f; } }
                __builtin_amdgcn_sched_barrier(0);
            }
#pragma unroll
            for (int sI = 0; sI < 4; ++sI)
#pragma unroll
                for (int d = 0; d < 4; ++d) o[d] = __builtin_amdgcn_mfma_f32_32x32x16_bf16(pf[sI], A2_VF(cb, d, sI), o[d], 0, 0, 0);
            float rm = -1e30f;
            if (has_next) rm = xhalf_max(rowmax32(n0, n1));
            SGB(0x100, 4);
#pragma unroll
            for (int i = 0; i < 12; ++i) { SGB(0x008, 1); SGB(0x100, 1); SGB(0x002, 2); }
#pragma unroll
            for (int i = 0; i < 4; ++i) { SGB(0x008, 1); SGB(0x002, 2); }
            __builtin_amdgcn_sched_barrier(0);
            if (__any(rm > THR)) {
                const float dl = __builtin_fmaxf(rm, 0.f), al = __builtin_amdgcn_exp2f(-dl);
                m_run += dl; l_run *= al;
#pragma unroll
                for (int r = 0; r < 16; ++r) { n0[r] -= dl; n1[r] -= dl; negm[r] = -m_run; }
                if (hh == 0) wsf[r32] = al;
                asm volatile("s_waitcnt lgkmcnt(0)" ::: "memory");
#pragma unroll
                for (int g = 0; g < 4; ++g) { const f32x4 a4 = *(const LAS f32x4*)(wsf + 8 * g + 4 * hh);
#pragma unroll
                    for (int d = 0; d < 4; ++d) { o[d][4 * g + 0] *= a4.x; o[d][4 * g + 1] *= a4.y; o[d][4 * g + 2] *= a4.z; o[d][4 * g + 3] *= a4.w; } }
                asm volatile("s_waitcnt lgkmcnt(0)" ::: "memory");
            }
            s0 = n0; s1 = n1;
        }
        asm volatile("s_waitcnt vmcnt(0) lgkmcnt(0)" ::: "memory");
        __builtin_amdgcn_s_barrier();
        asm volatile("" ::: "memory");
    }
    __builtin_amdgcn_s_setprio(0);
    l_run += __shfl_xor(l_run, 32);
    if (hh == 0) wsf[r32] = 1.0f / l_run;
    asm volatile("s_waitcnt lgkmcnt(0)" ::: "memory");
    LAS bf16_t* stg = (LAS bf16_t*)(lds + wid * 8192);
#pragma unroll
    for (int g = 0; g < 4; ++g) { const f32x4 a4 = *(const LAS f32x4*)(wsf + 8 * g + 4 * hh);
#pragma unroll
        for (int i = 0; i < 4; ++i) { const int row = 8 * g + 4 * hh + i; const float sc = (i == 0) ? a4.x : (i == 1) ? a4.y : (i == 2) ? a4.z : a4.w;
#pragma unroll
            for (int d = 0; d < 4; ++d) stg[row * 128 + d * 32 + r32] = (bf16_t)f2bf(o[d][4 * g + i] * sc); } }
    asm volatile("s_waitcnt lgkmcnt(0)" ::: "memory");
    { bf16_t* ob = O + (tokb + q0w) * DM + h * DV;
#pragma unroll
      for (int k = 0; k < 8; ++k) { const int chunk = k * 64 + lane, row = chunk >> 4, c16 = chunk & 15;
          const u32x4 v = *(const LAS u32x4*)(stg + row * 128 + c16 * 8); *(u32x4*)(ob + (size_t)row * DM + c16 * 8) = v; } }
    asm volatile("s_waitcnt lgkmcnt(0)" ::: "memory");
    __builtin_amdgcn_s_barrier();
    asm volatile("" ::: "memory");
#undef A2_DMA_K
#undef A2_DMA_V
#undef A2_KF
#undef A2_VF
}
__device__ __forceinline__ void attn_phase(LAS unsigned char* lds, int vcu, int G, const bf16_t* Q, const bf16_t* Kg, const bf16_t* VT, bf16_t* O, const float* gq, const float* rope) {
    for (int p = vcu; p < 256; p += G) {
        const int bh = p >> 4, s = p & 15;
        attn_unit(lds, bh >> 3, bh & 7, s, Q, Kg, VT, O, gq, rope);
        attn_unit(lds, bh >> 3, bh & 7, 31 - s, Q, Kg, VT, O, gq, rope);
    }
}
#undef SGB
}

__device__ __forceinline__ void transpose_item(const float* __restrict__ W, int N, int k0, int n0, bf16_t* dst, int ldk, const float* __restrict__ gain, LAS float* scr, int lane) {
    f32x4 v[8]; float gv[8];
#pragma unroll
    for (int i = 0; i < 8; ++i) { const int kk = 8 * i + (lane >> 3); v[i] = *(const f32x4*)(W + (size_t)(k0 + kk) * N + n0 + (lane & 7) * 4); gv[i] = gain ? gain[k0 + kk] : 1.0f; }
#pragma unroll
    for (int i = 0; i < 8; ++i) { const int kk = 8 * i + (lane >> 3); LAS float* p = scr + kk * 33 + (lane & 7) * 4; p[0] = v[i].x * gv[i]; p[1] = v[i].y * gv[i]; p[2] = v[i].z * gv[i]; p[3] = v[i].w * gv[i]; }
    asm volatile("s_waitcnt lgkmcnt(0)" ::: "memory");
    const int c = lane & 7;
#pragma unroll
    for (int j = 0; j < 4; ++j) { const int n = (lane >> 3) + 8 * j; const LAS float* s = scr + (8 * c) * 33 + n;
        u32x4 o; o.x = pk2(s[0 * 33], s[1 * 33]); o.y = pk2(s[2 * 33], s[3 * 33]); o.z = pk2(s[4 * 33], s[5 * 33]); o.w = pk2(s[6 * 33], s[7 * 33]);
        *(u32x4*)(dst + (size_t)n * ldk + k0 + 8 * c) = o; }
    asm volatile("s_waitcnt lgkmcnt(0)" ::: "memory");
}
struct In {
    const float* x; const int* pos; const float *g_mix, *g_mlp, *w_down, *g_q_a, *g_kv_a, *w_uq, *w_ukv, *g_qn, *g_kn, *w_o, *c_w_in, *c_w, *c_w_out, *w1, *w2;
};
struct MlaW { bf16_t *wd, *wuq, *wuk, *wuvt, *wo; };
struct ConvW { bf16_t *win, *wout; };
__device__ __forceinline__ MlaW mla_w(unsigned char* ws, int j) { MlaW w; bf16_t* p = (bf16_t*)(ws + WS_WMIX + (size_t)j * WMLA_BYTES);
    w.wd = p; p += DOWNP * DM; w.wuq = p; p += QW * QLORA; w.wuk = p; p += 1024 * KVLORA; w.wuvt = p; p += 1024 * KVLORA; w.wo = p; return w; }
__device__ __forceinline__ ConvW conv_w(unsigned char* ws, int j) { ConvW w; bf16_t* p = (bf16_t*)(ws + WS_WCONV + (size_t)j * WCONV_BYTES); w.win = p; w.wout = p + 3 * DM * DM; return w; }

__device__ __forceinline__ void convert_mlp(const In& in, unsigned char* ws, int L, LAS float* scr, int gw, int NGW, int lane) {
    bf16_t* w1t = (bf16_t*)(ws + WS_WMLP); bf16_t* w2t = w1t + (size_t)FF * DM;
    const float* w1 = in.w1 + (size_t)L * DM * FF; const float* w2 = in.w2 + (size_t)L * FF * DM; const float* g = in.g_mlp + L * DM;
    constexpr int I1 = (DM / 64) * (FF / 32), I2 = (FF / 64) * (DM / 32);
    for (int it = gw; it < I1 + I2; it += NGW) {
        if (it < I1) { const int kb = it / (FF / 32), nb = it % (FF / 32); transpose_item(w1, FF, kb * 64, nb * 32, w1t + (size_t)(nb * 32) * DM, DM, g, scr, lane); }
        else { const int r = it - I1, kb = r / (DM / 32), nb = r % (DM / 32); transpose_item(w2, DM, kb * 64, nb * 32, w2t + (size_t)(nb * 32) * FF, FF, nullptr, scr, lane); }
    }
}
__device__ __forceinline__ void convert_conv(const In& in, unsigned char* ws, int j, LAS float* scr, int gw, int NGW, int lane) {
    constexpr int I_IN = (DM / 64) * (3 * DM / 32), I_OUT = (DM / 64) * (DM / 32);
    const ConvW w = conv_w(ws, j);
    for (int r = gw; r < I_IN + I_OUT; r += NGW) {
        if (r < I_IN) { const int kb = r / (3 * DM / 32), nb = r % (3 * DM / 32), n0 = nb * 32;
            const int part = n0 >> 10, ch0 = n0 & 1023, drow = (part == 0) ? n0 : (1024 + (ch0 >> 7) * 256 + (part - 1) * 128 + (ch0 & 127));
            transpose_item(in.c_w_in + (size_t)j * DM * 3 * DM, 3 * DM, kb * 64, n0, w.win + (size_t)drow * DM, DM, in.g_mix + (2 * j + 1) * DM, scr, lane); }
        else { const int q = r - I_IN, kb = q / (DM / 32), nb = q % (DM / 32); transpose_item(in.c_w_out + (size_t)j * DM * DM, DM, kb * 64, nb * 32, w.wout + (size_t)(nb * 32) * DM, DM, nullptr, scr, lane); }
    }
}
__device__ __forceinline__ void prologue(const In& in, unsigned char* ws, LAS unsigned char* lds, int vcu, int G, int tid) {
    const int lane = tid & 63, wave = tid >> 6, gw = vcu * 8 + wave, NGW = G * 8;
    LAS float* scr = (LAS float*)(lds + wave * 16384);
    constexpr int I_D = (DM / 64) * (DOWN / 32), I_Q = (QLORA / 64) * (QW / 32), I_KV = (KVLORA / 64) * (2048 / 32), I_O = (DM / 64) * (DM / 32);
    constexpr int I_MLA = I_D + I_Q + I_KV + I_O;
    constexpr int I_IN = (DM / 64) * (3 * DM / 32), I_OUT = I_O, I_CONV = I_IN + I_OUT;
    for (int it = gw; it < 2 * I_MLA; it += NGW) {
        const int j = it / I_MLA; int r = it % I_MLA; const MlaW w = mla_w(ws, j);
        if (r < I_D) { const int kb = r / (DOWN / 32), nb = r % (DOWN / 32); transpose_item(in.w_down + (size_t)j * DM * DOWN, DOWN, kb * 64, nb * 32, w.wd + (size_t)(nb * 32) * DM, DM, in.g_mix + (2 * j) * DM, scr, lane); continue; } r -= I_D;
        if (r < I_Q) { const int kb = r / (QW / 32), nb = r % (QW / 32); transpose_item(in.w_uq + (size_t)j * QLORA * QW, QW, kb * 64, nb * 32, w.wuq + (size_t)(nb * 32) * QLORA, QLORA, in.g_q_a + j * QLORA, scr, lane); continue; } r -= I_Q;
        if (r < I_KV) { const int kb = r / 64, nb = r % 64, n0 = nb * 32, hd = n0 >> 8, j0 = n0 & 255;
            bf16_t* dst = (j0 < 128) ? (w.wuk + (size_t)(hd * 128 + j0) * KVLORA) : (w.wuvt + (size_t)(hd * 128 + j0 - 128) * KVLORA);
            transpose_item(in.w_ukv + (size_t)j * KVLORA * 2048, 2048, kb * 64, n0, dst, KVLORA, in.g_kv_a + j * KVLORA, scr, lane); continue; } r -= I_KV;
        { const int kb = r / (DM / 32), nb = r % (DM / 32); transpose_item(in.w_o + (size_t)j * DM * DM, DM, kb * 64, nb * 32, w.wo + (size_t)(nb * 32) * DM, DM, nullptr, scr, lane); }
    }
    { const int gt = vcu * 512 + tid, NT = G * 512;
      for (int i = gt; i < 2 * (DOWNP - DOWN) * DM / 8; i += NT) { const int j = i / ((DOWNP - DOWN) * DM / 8), r = i % ((DOWNP - DOWN) * DM / 8);
          *(u32x4*)(mla_w(ws, j).wd + (size_t)DOWN * DM + (size_t)r * 8) = (u32x4){0u, 0u, 0u, 0u}; }
      float* rope = (float*)(ws + WS_ROPE);
      for (int i = gt; i < MT * 32; i += NT) { const int tok = i >> 5, f = i & 31;
          const float inv = (float)exp2(-(double)f * (13.287712379549449 / 32.0));
          const float ang = (float)in.pos[tok] * inv;
          float sn_, cs_; sincosf(ang, &sn_, &cs_);
          rope[(size_t)tok * 64 + f] = cs_; rope[(size_t)tok * 64 + 32 + f] = sn_; }
    }
    bf16_t* xb = (bf16_t*)(ws + WS_XA); float* ssx = (float*)(ws + WS_SSX);
    for (int m = gw; m < MT; m += 2 * NGW) {
        const int m2 = m + NGW; const bool has2 = m2 < MT;
        const f32x4* xr = (const f32x4*)(in.x + (size_t)m * DM) + lane; const f32x4* xr2 = (const f32x4*)(in.x + (size_t)(has2 ? m2 : m) * DM) + lane;
        f32x4 va[4], vb[4];
#pragma unroll
        for (int j = 0; j < 4; ++j) { va[j] = xr[64 * j]; vb[j] = xr2[64 * j]; }
        float s = 0.f, s2 = 0.f;
        unsigned long long* o8 = (unsigned long long*)(xb + (size_t)m * DM) + lane; unsigned long long* o82 = (unsigned long long*)(xb + (size_t)m2 * DM) + lane;
#pragma unroll
        for (int j = 0; j < 4; ++j) { const f32x4 v = va[j]; s += (v.x * v.x + v.y * v.y) + (v.z * v.z + v.w * v.w);
            o8[64 * j] = (unsigned long long)pk2(v.x, v.y) | ((unsigned long long)pk2(v.z, v.w) << 32); }
        if (has2) {
#pragma unroll
            for (int j = 0; j < 4; ++j) { const f32x4 v = vb[j]; s2 += (v.x * v.x + v.y * v.y) + (v.z * v.z + v.w * v.w);
                o82[64 * j] = (unsigned long long)pk2(v.x, v.y) | ((unsigned long long)pk2(v.z, v.w) << 32); }
        }
        s = wave_sum(s); s2 = wave_sum(s2);
        if (lane < 16) { ssx[(size_t)m * 16 + lane] = (lane == 0) ? s : 0.f; if (has2) ssx[(size_t)m2 * 16 + lane] = (lane == 0) ? s2 : 0.f; }
    }
}
__device__ __forceinline__ void qk_head24(u32x4& c0, u32x4& c1, u32x4& c2, const float (&g)[24], const float (&cs)[8], const float (&sn)[8], int s, float osc) {
    float e[24];
    e[0] = bflo(c0.x); e[1] = bfhi(c0.x); e[2] = bflo(c0.y); e[3] = bfhi(c0.y); e[4] = bflo(c0.z); e[5] = bfhi(c0.z); e[6] = bflo(c0.w); e[7] = bfhi(c0.w);
    e[8] = bflo(c1.x); e[9] = bfhi(c1.x); e[10] = bflo(c1.y); e[11] = bfhi(c1.y); e[12] = bflo(c1.z); e[13] = bfhi(c1.z); e[14] = bflo(c1.w); e[15] = bfhi(c1.w);
    e[16] = bflo(c2.x); e[17] = bfhi(c2.x); e[18] = bflo(c2.y); e[19] = bfhi(c2.y); e[20] = bflo(c2.z); e[21] = bfhi(c2.z); e[22] = bflo(c2.w); e[23] = bfhi(c2.w);
    float ss = 0.f;
#pragma unroll
    for (int i = 0; i < 24; ++i) ss += e[i] * e[i];
    ss += __shfl_xor(ss, 1); ss += __shfl_xor(ss, 2); ss += __shfl_xor(ss, 4);
    const float rs = rsqrtf(ss * (1.0f / DQK) + EPS);
#pragma unroll
    for (int i = 0; i < 24; ++i) e[i] = e[i] * rs * g[i];
#pragma unroll
    for (int i = 0; i < 8; ++i) { const float pr = __shfl_xor(e[16 + i], 4); e[16 + i] = (s < 4) ? (e[16 + i] * cs[i] - pr * sn[i]) : (e[16 + i] * cs[i] + pr * sn[i]); }
#pragma unroll
    for (int i = 0; i < 24; ++i) e[i] *= osc;
    c0.x = pk2(e[0], e[1]); c0.y = pk2(e[2], e[3]); c0.z = pk2(e[4], e[5]); c0.w = pk2(e[6], e[7]);
    c1.x = pk2(e[8], e[9]); c1.y = pk2(e[10], e[11]); c1.z = pk2(e[12], e[13]); c1.w = pk2(e[14], e[15]);
    c2.x = pk2(e[16], e[17]); c2.y = pk2(e[18], e[19]); c2.z = pk2(e[20], e[21]); c2.w = pk2(e[22], e[23]);
}
__device__ __forceinline__ void knorm_unit(const float* __restrict__ gk, const float* __restrict__ gq, const float* __restrict__ rope, bf16_t* kb, const bf16_t* __restrict__ a, int pm, int pn, int tid) {
    const int lane = tid & 63, wave = tid >> 6, slot = lane >> 3, s = lane & 7;
    float gkv[24];
#pragma unroll
    for (int c = 0; c < 3; ++c)
#pragma unroll
        for (int i = 0; i < 8; ++i) gkv[8 * c + i] = gk[64 * c + 8 * s + i] * (c < 2 ? gq[64 * c + 8 * s + i] : 1.0f);
#pragma unroll 1
    for (int bt = 0; bt < 2; ++bt) {
        u32x4 k0[4], k1[4], k2[4]; f32x4 rc[4][2], rsn[4][2];
#pragma unroll
        for (int q4 = 0; q4 < 4; ++q4) { const int it = bt * 4 + q4, tok = pm * 256 + wave * 32 + it * 4 + (slot >> 1), hd = 2 * pn + (slot & 1);
            const bf16_t* kr = kb + (size_t)tok * QW + hd * DQK + 8 * s;
            k0[q4] = *(const u32x4*)(kr); k1[q4] = *(const u32x4*)(kr + 64); k2[q4] = *(const u32x4*)(a + (size_t)tok * DOWNP + 384 + 8 * s);
            rc[q4][0] = *(const f32x4*)(rope + (size_t)tok * 64 + 8 * (s & 3)); rc[q4][1] = *(const f32x4*)(rope + (size_t)tok * 64 + 8 * (s & 3) + 4);
            rsn[q4][0] = *(const f32x4*)(rope + (size_t)tok * 64 + 32 + 8 * (s & 3)); rsn[q4][1] = *(const f32x4*)(rope + (size_t)tok * 64 + 32 + 8 * (s & 3) + 4); }
        asm volatile("" ::: "memory");
#pragma unroll
        for (int q4 = 0; q4 < 4; ++q4) { const int it = bt * 4 + q4, tok = pm * 256 + wave * 32 + it * 4 + (slot >> 1), hd = 2 * pn + (slot & 1);
            bf16_t* kr = kb + (size_t)tok * QW + hd * DQK + 8 * s;
            float cs[8], sn[8];
            cs[0] = rc[q4][0].x; cs[1] = rc[q4][0].y; cs[2] = rc[q4][0].z; cs[3] = rc[q4][0].w; cs[4] = rc[q4][1].x; cs[5] = rc[q4][1].y; cs[6] = rc[q4][1].z; cs[7] = rc[q4][1].w;
            sn[0] = rsn[q4][0].x; sn[1] = rsn[q4][0].y; sn[2] = rsn[q4][0].z; sn[3] = rsn[q4][0].w; sn[4] = rsn[q4][1].x; sn[5] = rsn[q4][1].y; sn[6] = rsn[q4][1].z; sn[7] = rsn[q4][1].w;
            qk_head24(k0[q4], k1[q4], k2[q4], gkv, cs, sn, s, 1.0f);
            *(u32x4*)(kr) = k0[q4]; *(u32x4*)(kr + 64) = k1[q4]; *(u32x4*)(kr + 128) = k2[q4]; }
        asm volatile("" ::: "memory");
    }
}
__device__ __forceinline__ void conv_gate(const float* __restrict__ cw  , const bf16_t* __restrict__ bcu, bf16_t* __restrict__ y, int vcu, int G, int tid) {
    constexpr int CHUNK = 16, LD = 2 * DM;
    const int gt = vcu * 512 + tid, NT = G * 512;
    for (int i = gt; i < (MT / CHUNK) * (DM / 8); i += NT) {
        const int c8 = (i & 127) * 8, tok0 = (i >> 7) * CHUNK, t0 = tok0 & (SEQ - 1);
        float w[3][8];
#pragma unroll
        for (int k = 0; k < 3; ++k) { const f32x4 a0 = *(const f32x4*)(cw + k * DM + c8), a1 = *(const f32x4*)(cw + k * DM + c8 + 4);
            w[k][0] = a0.x; w[k][1] = a0.y; w[k][2] = a0.z; w[k][3] = a0.w; w[k][4] = a1.x; w[k][5] = a1.y; w[k][6] = a1.z; w[k][7] = a1.w; }
        float p1[8], p2[8];
#pragma unroll
        for (int e = 0; e < 8; ++e) { p1[e] = 0.f; p2[e] = 0.f; }
        if (t0 > 0) {
            const u32x4 u2 = *(const u32x4*)(bcu + (size_t)(tok0 - 2) * LD + DM + c8), u1 = *(const u32x4*)(bcu + (size_t)(tok0 - 1) * LD + DM + c8);
            p2[0] = bflo(u2.x); p2[1] = bfhi(u2.x); p2[2] = bflo(u2.y); p2[3] = bfhi(u2.y); p2[4] = bflo(u2.z); p2[5] = bfhi(u2.z); p2[6] = bflo(u2.w); p2[7] = bfhi(u2.w);
            p1[0] = bflo(u1.x); p1[1] = bfhi(u1.x); p1[2] = bflo(u1.y); p1[3] = bfhi(u1.y); p1[4] = bflo(u1.z); p1[5] = bfhi(u1.z); p1[6] = bflo(u1.w); p1[7] = bfhi(u1.w);
        }
#pragma unroll 4
        for (int k = 0; k < CHUNK; ++k) {
            const bf16_t* row = bcu + (size_t)(tok0 + k) * LD;
            const u32x4 gb = *(const u32x4*)(row + c8), uc = *(const u32x4*)(row + DM + c8);
            float p0[8], gbf[8];
            p0[0] = bflo(uc.x); p0[1] = bfhi(uc.x); p0[2] = bflo(uc.y); p0[3] = bfhi(uc.y); p0[4] = bflo(uc.z); p0[5] = bfhi(uc.z); p0[6] = bflo(uc.w); p0[7] = bfhi(uc.w);
            gbf[0] = bflo(gb.x); gbf[1] = bfhi(gb.x); gbf[2] = bflo(gb.y); gbf[3] = bfhi(gb.y); gbf[4] = bflo(gb.z); gbf[5] = bfhi(gb.z); gbf[6] = bflo(gb.w); gbf[7] = bfhi(gb.w);
            float o[8];
#pragma unroll
            for (int e = 0; e < 8; ++e) { o[e] = gbf[e] * (w[0][e] * p2[e] + w[1][e] * p1[e] + w[2][e] * p0[e]); p2[e] = p1[e]; p1[e] = p0[e]; }
            u32x4 ov; ov.x = pk2(o[0], o[1]); ov.y = pk2(o[2], o[3]); ov.z = pk2(o[4], o[5]); ov.w = pk2(o[6], o[7]);
            *(u32x4*)(y + (size_t)(tok0 + k) * DM + c8) = ov;
        }
    }
}

#define XB_TMO      128
#define XB_XCNT(j)  (256  + 64 * (j))
#define XB_XSUB(j)  (1280 + 64 * (j))
#define XB_XGEN(j)  (2304 + 64 * (j))
#define XB_TOP      3328
#define XB_TOPGEN   3392
#define XCD_BAR_WORDS 3456
#define XB_SPIN_CAP (1u << 18)
__device__ __forceinline__ unsigned xb_ld(unsigned* p)              { return __hip_atomic_load(p, __ATOMIC_RELAXED, __HIP_MEMORY_SCOPE_AGENT); }
__device__ __forceinline__ unsigned xb_add(unsigned* p, unsigned v) { return __hip_atomic_fetch_add(p, v, __ATOMIC_RELAXED, __HIP_MEMORY_SCOPE_AGENT); }
__device__ __forceinline__ unsigned xb_xcc_id() { return (unsigned)__builtin_amdgcn_s_getreg((3 << 11) | 20) & 0xFu; }
#define XB_SPIN(cond, bar) do { unsigned _sp = 0; while (cond) { __builtin_amdgcn_s_sleep(1); \
    if ((++_sp & 255u) == 0u) { if (xb_ld(&(bar)[XB_TMO])) break; if (_sp > XB_SPIN_CAP) { atomicAdd(&(bar)[XB_TMO], 1u); break; } } } } while (0)
struct XcdBarrier { unsigned* bar; unsigned x; volatile LAS unsigned* st; };
__device__ __forceinline__ XcdBarrier xcd_barrier_post(unsigned* bar, volatile LAS unsigned* st) {
    XcdBarrier b; b.bar = bar; b.x = xb_xcc_id(); b.st = st;
    if (threadIdx.x == 0) (void)xb_add(&bar[XB_XCNT(b.x)], 1u);
    return b;
}
__device__ __forceinline__ void xcd_barrier_complete(unsigned* bar, unsigned x, unsigned& nloc, unsigned& nx) {
    const unsigned G = gridDim.x * gridDim.y * gridDim.z;
    unsigned sum, cnt, mine, sp = 0u;
    for (;;) {
        sum = 0u; cnt = 0u; mine = 0u;
#pragma unroll
        for (unsigned j = 0; j < 16; ++j) { const unsigned c = xb_ld(&bar[XB_XCNT(j)]); sum += c; cnt += (c > 0u) ? 1u : 0u; mine = (j == x) ? c : mine; }
        if (sum == G) break;
        __builtin_amdgcn_s_sleep(1);
        if ((++sp & 255u) == 0u) { if (xb_ld(&bar[XB_TMO])) break; if (sp > XB_SPIN_CAP) { atomicAdd(&bar[XB_TMO], 1u); break; } }
    }
    nloc = mine > 0u ? mine : 1u; nx = cnt > 0u ? cnt : 1u;
}
__device__ __forceinline__ void xcd_barrier(const XcdBarrier& b) {
    asm volatile("s_waitcnt vmcnt(0)" ::: "memory");
    __syncthreads();
    if (threadIdx.x == 0) {
        unsigned* bar = b.bar;
        __builtin_amdgcn_s_waitcnt(0);
        unsigned nloc = b.st[0], nx = b.st[1];
        if (nloc == 0u) { xcd_barrier_complete(bar, b.x, nloc, nx); b.st[0] = nloc; b.st[1] = nx; }
        const unsigned old = xb_add(&bar[XB_XSUB(b.x)], 1u);
        const unsigned gen = old / nloc;
        if (old + 1u == (gen + 1u) * nloc) {
            __builtin_amdgcn_fence(__ATOMIC_RELEASE, "agent");
            asm volatile("s_waitcnt vmcnt(0)" ::: "memory");
            const unsigned og = xb_add(&bar[XB_TOP], 1u);
            const unsigned tg = og / nx;
            if (og + 1u == (tg + 1u) * nx) xb_add(&bar[XB_TOPGEN], 1u);
            else XB_SPIN(xb_ld(&bar[XB_TOPGEN]) == tg, bar);
            __builtin_amdgcn_fence(__ATOMIC_ACQUIRE, "agent");
            xb_add(&bar[XB_XGEN(b.x)], 1u);
            asm volatile("s_waitcnt vmcnt(0)" ::: "memory");
        } else {
            XB_SPIN(xb_ld(&bar[XB_XGEN(b.x)]) == gen, bar);
            __builtin_amdgcn_fence(__ATOMIC_ACQUIRE, "agent");
            asm volatile("s_waitcnt vmcnt(0)" ::: "memory");
        }
    }
    __syncthreads();
}

constexpr int RING_BYTES = 131072, MISC_OFF = RING_BYTES + 320, LDS_BYTES = 147456;
static_assert(att2::L_END <= RING_BYTES && pg8::STAGE_BYTES <= RING_BYTES, "LDS map");
constexpr int PH_PER_LAYER = 7, NPH = 1 + NLAYER * PH_PER_LAYER;
struct Args { In in; float* out; unsigned char* ws; int ph_lo, ph_hi, nogemm, noattn; };

__global__ void __launch_bounds__(512, 2) mk_fwd(Args args) {
    extern __shared__ __attribute__((aligned(16))) unsigned char lds_raw[];
    LAS unsigned char* lds = (LAS unsigned char*)lds_raw;
    const int tid = threadIdx.x, G = gridDim.x, bx = blockIdx.x;
    const int vcu = (G % 8 == 0) ? (bx % 8) * (G / 8) + bx / 8 : bx;
    unsigned char* ws = args.ws; const In& in = args.in;
    const int lo = args.ph_lo, hi = args.ph_hi;
    cg::grid_group grid = cg::this_grid();
    volatile LAS unsigned* MISC = (volatile LAS unsigned*)(lds + MISC_OFF);
    if (tid < 32) MISC[tid] = 0u;
    __syncthreads();
#define GRID_BAR() xcd_barrier(bar)
#define IN(k) (lo <= (k) && (k) < hi)
#define SEAM(k) do { if (IN(k) && IN((k) + 1)) GRID_BAR(); } while (0)

    if (bx == 0) { unsigned* bw = (unsigned*)(ws + WS_CTL) + 1024; for (int i = tid; i < XCD_BAR_WORDS; i += 512) bw[i] = 0u; }
    prologue(in, ws, lds, vcu, G, tid);
    grid.sync();
    XcdBarrier bar = xcd_barrier_post((unsigned*)(ws + WS_CTL) + 1024, MISC + 8);
    bf16_t* cur = (bf16_t*)(ws + WS_XA); bf16_t* alt = (bf16_t*)(ws + WS_XC);
    bf16_t* big = (bf16_t*)(ws + WS_BIG);
    float* ssx = (float*)(ws + WS_SSX); float* ssa = (float*)(ws + WS_SSA);
    bf16_t* w1t = (bf16_t*)(ws + WS_WMLP); bf16_t* w2t = w1t + (size_t)FF * DM;
    for (int L = 0; L < NLAYER; ++L) {
        const int base = 1 + L * PH_PER_LAYER, j = L >> 1; const bool mla = !(L & 1);
        int tl = tid; asm volatile("" : "+v"(tl));
        if (IN(base + 0)) {
            constexpr int NU_DOWN = (MT / 256) * (DOWNP / 256);
            { const bool idle_only = mla && G > NU_DOWN && !args.nogemm;
              const int cgw = (idle_only ? (bx - NU_DOWN) : vcu) * 8 + (tl >> 6), cngw = (idle_only ? (G - NU_DOWN) : G) * 8;
              if (!idle_only || bx >= NU_DOWN) {
                  convert_mlp(in, ws, L, (LAS float*)(lds + (tl >> 6) * 16384), cgw, cngw, tl & 63);
                  if (mla) convert_conv(in, ws, j, (LAS float*)(lds + (tl >> 6) * 16384), cgw, cngw, tl & 63);
              } }
            __syncthreads();
            if (!args.nogemm) {
                if (mla) {
                    pg8::Gemm g{cur, mla_w(ws, j).wd, MT, DOWNP, DM, DM, DM}; pg8::StaticOrder S; S.init(MT, DOWNP, G, bx);
                    int tpm = -1; { pg8::Unit u0; if (S.next(0, u0)) { tpm = u0.pm; pg8::fill_rstd_tab((LAS float*)(lds + RING_BYTES + 1024), ssx, 16, 4, 1.0f / DM, tpm, tl); } } __syncthreads();
                    pg8::EpiScale<0, 0, 1> E{alt, DOWNP, ssx, 16, 4, 1.0f / DM, ssa, (LAS float*)(lds + RING_BYTES + 1024), tpm};
                    if (DBG_ON(0)) pg8::gemm_phase<pg8::EpiScale<0, 0, 1>, pg8::StaticOrder, true>(lds, g, S, E);
                } else {
                    pg8::Gemm g{cur, conv_w(ws, j).win, MT, 3 * DM, DM, DM, DM}; pg8::StaticOrder S; S.init(MT, 3 * DM, G, bx);
                    int tpm = -1; { pg8::Unit u0; if (S.next(0, u0)) { tpm = u0.pm; pg8::fill_rstd_tab((LAS float*)(lds + RING_BYTES + 1024), ssx, 16, 4, 1.0f / DM, tpm, tl); } } __syncthreads();
                    pg8::EpiConvIn E{big, ssx, (LAS float*)(lds + RING_BYTES + 1024), tpm};
                    if (DBG_ON(1)) pg8::gemm_phase<pg8::EpiConvIn, pg8::StaticOrder, true>(lds, g, S, E);
                }
            }
        }
        if (mla) {
            bf16_t* qb = big; bf16_t* kb = big + (size_t)MT * QW; bf16_t* vt = kb + (size_t)MT * QW;
            SEAM(base + 0);
            if (IN(base + 1) && !args.nogemm) {
                const MlaW w = mla_w(ws, j);
                { pg8::Gemm g{alt, w.wuq, MT, QW, QLORA, DOWNP, QLORA}; pg8::StaticOrder S; S.init(MT, QW, G, bx);
                  pg8::EpiScale<0, 0, 0> E{qb, QW, ssa, 8, 1, 1.0f / QLORA, nullptr, nullptr, -1};
                  if (DBG_ON(2)) pg8::gemm_phase<pg8::EpiScale<0, 0, 0>, pg8::StaticOrder, true>(lds, g, S, E); }
                { pg8::Gemm g{alt + QLORA, w.wuk, MT, 1024, KVLORA, DOWNP, KVLORA}; pg8::StaticOrder S; S.init(MT, 1024, G, bx);
                  pg8::EpiScale<0, 1, 0> E{kb, QW, ssa + 4, 8, 1, 1.0f / KVLORA, nullptr, nullptr, -1};
                  if (DBG_ON(3)) pg8::gemm_phase<pg8::EpiScale<0, 1, 0>, pg8::StaticOrder, true>(lds, g, S, E);
                  if ((tl >> 6) == 0) __builtin_amdgcn_fence(__ATOMIC_ACQUIRE, "agent");
                  asm volatile("s_waitcnt vmcnt(0)" ::: "memory"); __syncthreads();
                  pg8::Unit u; for (int i = 0; S.next(i, u); ++i) knorm_unit(in.g_kn + j * DQK, in.g_qn + j * DQK, (const float*)(ws + WS_ROPE), kb, alt, u.pm, u.pn, tl); }
                { pg8::Gemm g{w.wuvt, alt + QLORA, 1024, MT, KVLORA, KVLORA, DOWNP}; pg8::StaticOrder S; S.init(1024, MT, G, bx);
                  pg8::EpiVT E{vt, MT, ssa};
                  if (DBG_ON(4)) pg8::gemm_phase<pg8::EpiVT, pg8::StaticOrder, true>(lds, g, S, E); }
            }
            SEAM(base + 1);
                        if (IN(base + 3) && !args.noattn) ATT_NS::attn_phase(lds, vcu, G, qb, kb, vt, alt, in.g_qn + j * DQK, (const float*)(ws + WS_ROPE));
            SEAM(base + 3);
            if (IN(base + 4) && !args.nogemm) {
                pg8::Gemm g{alt, mla_w(ws, j).wo, MT, DM, DM, DM, DM}; pg8::StaticOrder S; S.init(MT, DM, G, bx);
                pg8::EpiResid<false> E{cur, nullptr, ssx};
                if (DBG_ON(5)) pg8::gemm_phase<pg8::EpiResid<false>, pg8::StaticOrder, true>(lds, g, S, E);
            }
            SEAM(base + 4);
        } else {
            SEAM(base + 0);
            if (IN(base + 2)) conv_gate(in.c_w + (size_t)j * 3 * DM, big, alt, vcu, G, tl);
            if (IN(base + 2) && IN(base + 4)) GRID_BAR();
            if (IN(base + 4) && !args.nogemm) {
                pg8::Gemm g{alt, conv_w(ws, j).wout, MT, DM, DM, DM, DM}; pg8::StaticOrder S; S.init(MT, DM, G, bx);
                pg8::EpiResid<false> E{cur, nullptr, ssx};
                if (DBG_ON(6)) pg8::gemm_phase<pg8::EpiResid<false>, pg8::StaticOrder, true>(lds, g, S, E);
            }
            SEAM(base + 4);
        }
        if (IN(base + 5) && !args.nogemm) {
            pg8::Gemm g{cur, w1t, MT, FF, DM, DM, DM}; pg8::StaticOrder S; S.init(MT, FF, G, bx);
            int tpm = -1; { pg8::Unit u0; if (S.next(0, u0)) { tpm = u0.pm; pg8::fill_rstd_tab((LAS float*)(lds + RING_BYTES + 1024), ssx, 16, 4, 1.0f / DM, tpm, tl); } } __syncthreads();
            pg8::EpiScale<1, 0, 0> E{big, FF, ssx, 16, 4, 1.0f / DM, nullptr, (LAS float*)(lds + RING_BYTES + 1024), tpm};
            if (DBG_ON(7)) pg8::gemm_phase<pg8::EpiScale<1, 0, 0>, pg8::StaticOrder, true>(lds, g, S, E);
        }
        SEAM(base + 5);
        if (IN(base + 6) && !args.nogemm) {
            pg8::Gemm g{big, w2t, MT, DM, FF, FF, FF}; pg8::StaticOrder S; S.init(MT, DM, G, bx);
            if (L + 1 < NLAYER) { pg8::EpiResid<false> E{cur, nullptr, ssx};
                if (DBG_ON(8)) pg8::gemm_phase<pg8::EpiResid<false>, pg8::StaticOrder, true>(lds, g, S, E); }
            else { pg8::EpiResid<true> E{cur, args.out, ssx};
                if (DBG_ON(8)) pg8::gemm_phase<pg8::EpiResid<true>, pg8::StaticOrder, true>(lds, g, S, E); }
        }
        if (L + 1 < NLAYER) SEAM(base + 6);
    }
#undef IN
#undef SEAM
}

extern "C" void kernel_launch(void* const* d_in, const int* in_sizes, int n_in, void* d_out, int out_size, void* d_ws, size_t ws_size, hipStream_t stream) {
    static int grid = 0;
    if (grid == 0) {
        if (n_in != 17 || out_size != MT * DM || ws_size < WS_END) { fprintf(stderr, "kernel_launch: unexpected problem shape (n_in %d, out %d, ws %zu)\n", n_in, out_size, ws_size); grid = -1; return; }
        int dev = 0, cus = 0, per_cu = 0;
        hipGetDevice(&dev); hipDeviceGetAttribute(&cus, hipDeviceAttributeMultiprocessorCount, dev);
        if (hipFuncSetAttribute((const void*)mk_fwd, hipFuncAttributeMaxDynamicSharedMemorySize, LDS_BYTES) != hipSuccess) { fprintf(stderr, "kernel_launch: hipFuncSetAttribute failed\n"); grid = -1; return; }
        if (hipOccupancyMaxActiveBlocksPerMultiprocessor(&per_cu, (const void*)mk_fwd, 512, LDS_BYTES) != hipSuccess || per_cu < 1) { fprintf(stderr, "kernel_launch: occupancy query says %d\n", per_cu); per_cu = 1; }
        (void)hipGetLastError();
        grid = cus * per_cu;
    }
    if (grid < 0) return;
    Args a{};
    const void** ip = (const void**)&a.in;
    for (int i = 0; i < 17; ++i) ip[i] = d_in[i];
    a.out = (float*)d_out; a.ws = (unsigned char*)d_ws; a.nogemm = 0; a.noattn = 0;
    a.ph_lo = 0; a.ph_hi = NPH;
    void* kargs[] = {&a};
    hipError_t e = hipLaunchCooperativeKernel((const void*)mk_fwd, dim3(grid), dim3(512), kargs, LDS_BYTES, stream);
    if (e != hipSuccess) fprintf(stderr, "kernel_launch: cooperative launch failed: %s (grid %d)\n", hipGetErrorString(e), grid);
}
```

```cpp
#include <hip/hip_runtime.h>
#include <hip/hip_cooperative_groups.h>
#include <cstdio>
#include <cstdint>
namespace cg = cooperative_groups;

#ifndef DBG_MASK
#define DBG_MASK 0xffff
#endif
#define DBG_ON(k) ((DBG_MASK >> (k)) & 1)
#define ATT_NS att2

constexpr int NB = 2, SEQ = 8192, DM = 1024, MT = NB * SEQ, NH = 8, DQK = 192, DNOPE = 128, DROPE = 64, DV = 128;
constexpr int QLORA = 256, KVLORA = 128, DOWN = 448, DOWNP = 512, FF = 4096, NLAYER = 4;
constexpr int QW = NH * DQK;
constexpr float EPS = 1e-6f;
constexpr float QSCALE = 0.07216878364870322f * 1.4426950408889634f;

typedef unsigned short bf16_t;
typedef short bf16x8 __attribute__((ext_vector_type(8)));
typedef float f32x4 __attribute__((ext_vector_type(4)));
typedef float f32x16 __attribute__((ext_vector_type(16)));
typedef unsigned u32x4 __attribute__((ext_vector_type(4)));
typedef unsigned u32x2 __attribute__((ext_vector_type(2)));
#define LAS __attribute__((address_space(3)))

constexpr size_t MiB = 1u << 20;
constexpr size_t WS_CTL = 0;
constexpr size_t WS_SSX = 1 * MiB;
constexpr size_t WS_SSA = 2 * MiB;
constexpr size_t WS_ROPE = 3 * MiB;
constexpr size_t WS_WMIX = 8 * MiB;
constexpr size_t WMLA_BYTES = (size_t)(DOWNP * DM + QW * QLORA + 1024 * KVLORA + 1024 * KVLORA + DM * DM) * 2;
constexpr size_t WCONV_BYTES = (size_t)(3 * DM * DM + DM * DM) * 2;
constexpr size_t WS_WCONV = WS_WMIX + 2 * WMLA_BYTES;
constexpr size_t WS_WMLP = 34 * MiB;
constexpr size_t WS_XA = 52 * MiB, WS_XC = 84 * MiB;
constexpr size_t WS_BIG = 116 * MiB;
constexpr size_t WS_END = 244 * MiB;
static_assert(WS_WCONV + 2 * WCONV_BYTES <= WS_WMLP && WS_WMLP + 16 * MiB <= WS_XA, "ws map");

__device__ __forceinline__ unsigned f2bf(float f) { unsigned u = __builtin_bit_cast(unsigned, f); return (u + 0x7fffu + ((u >> 16) & 1u)) >> 16; }
__device__ __forceinline__ unsigned pk2(float lo, float hi) { return f2bf(lo) | (f2bf(hi) << 16); }
__device__ __forceinline__ float bf2f(bf16_t v) { return __builtin_bit_cast(float, (unsigned)v << 16); }
__device__ __forceinline__ float bflo(unsigned w) { return __builtin_bit_cast(float, w << 16); }
__device__ __forceinline__ float bfhi(unsigned w) { return __builtin_bit_cast(float, w & 0xffff0000u); }
__device__ __forceinline__ float wave_sum(float v) {
#pragma unroll
    for (int o = 1; o < 64; o <<= 1) v += __shfl_xor(v, o);
    return v;
}
__device__ __forceinline__ float wave_max(float v) {
#pragma unroll
    for (int o = 1; o < 64; o <<= 1) v = fmaxf(v, __shfl_xor(v, o));
    return v;
}
__device__ __forceinline__ float rstd_from(const float* ssp, int n4, float inv_dim) {
    float s = 0.f;
    for (int i = 0; i < n4; ++i) { const f32x4 v = ((const f32x4*)ssp)[i]; s += (v.x + v.y) + (v.z + v.w); }
    return rsqrtf(s * inv_dim + EPS);
}

namespace pg8 {
constexpr int BM = 256, BK = 64, HALF = 128, HTB = HALF * BK * 2, STAGE_BYTES = 8 * HTB, NXCD = 8, WGM = 8;
__host__ __device__ __forceinline__ int lds_byte(int r, int c) { const int st = (r >> 4) * 2 + (c >> 5), rr = r & 15, cc = c & 31, ob = rr * 64 + cc * 2; return st * 1024 + (ob ^ (((ob >> 9) & 1) << 5)); }
__host__ __device__ __forceinline__ void stage_rc(int b, int& R, int& C) { const int st = b / 1024, sb = b % 1024, swz = sb ^ (((sb >> 9) & 1) << 5); R = (st >> 1) * 16 + swz / 64; C = (st & 1) * 32 + (swz % 64) / 2; }
__host__ __device__ __forceinline__ int perm32(int rho) { const int n = rho >> 4, i = rho & 15; return 8 * (i >> 2) + 4 * n + (i & 3); }

struct Unit { int pm, pn; };
struct Gemm { const bf16_t* A; const bf16_t* Bt; int M, N, K, lda, ldb; };

struct StaticOrder {
    int nM, nN, nwg, G, c;
    __host__ __device__ void init(int M, int N, int G_, int c_) { nM = M / BM; nN = N / BM; nwg = nM * nN; G = G_; c = c_; }
    __host__ __device__ bool next(int i, Unit& u) const {
        const long L = (long)i * G + c; if (L >= nwg) return false;
        int wgid = (int)L; { const int q = nwg / NXCD, r = nwg % NXCD, xcd = wgid % NXCD, off = wgid / NXCD; wgid = (xcd < r ? xcd * (q + 1) : r * (q + 1) + (xcd - r) * q) + off; }
        const int nig = WGM * nN, gid = wgid / nig, fm = gid * WGM, gsz = (nM - fm) < WGM ? (nM - fm) : WGM;
        u.pm = fm + ((wgid % nig) % gsz); u.pn = (wgid % nig) / gsz; return true;
    }
};

__device__ __forceinline__ unsigned cvt_pk_bf16(float lo, float hi) { unsigned r; asm volatile("v_cvt_pk_bf16_f32 %0, %1, %2" : "=v"(r) : "v"(lo), "v"(hi)); return r; }

template <int ACT  , int REMAP  , int SSMODE> struct EpiScale {
    static constexpr bool PERM = true;
    bf16_t* O; int ldc; const float* ssp; int ss_stride, ss_n4; float inv_dim; float* ss_out;
    const LAS float* tab; int tab_pm;
    __device__ __forceinline__ void operator()(const f32x4 (&acc)[2][2][4][2], const Unit& u, int wr, int wc, int fr, int fq) const {
        const int row0 = u.pm * BM + wr * 64 + fr, colt = u.pn * BM + wc * 32 + 8 * fq;
        float rsv[2][4];
#pragma unroll
        for (int ai = 0; ai < 2; ++ai)
#pragma unroll
            for (int m = 0; m < 4; ++m) rsv[ai][m] = (u.pm == tab_pm) ? tab[wr * 64 + fr + ai * HALF + m * 16] : rstd_from(ssp + (size_t)(row0 + ai * HALF + m * 16) * ss_stride, ss_n4, inv_dim);
#pragma unroll
        for (int ai = 0; ai < 2; ++ai)
#pragma unroll
            for (int m = 0; m < 4; ++m) {
                const int row = row0 + ai * HALF + m * 16;
                const float rs = rsv[ai][m];
                float ssq = 0.f;
#pragma unroll
                for (int bj = 0; bj < 2; ++bj) {
                    const int col = colt + bj * HALF, dcol = REMAP ? ((col >> 7) * 192 + (col & 127)) : col;
                    f32x4 v0 = acc[ai][bj][m][0] * rs, v1 = acc[ai][bj][m][1] * rs;
                    if (SSMODE == 1) { if (u.pn == 0 || bj == 0) ssq += (v0.x * v0.x + v0.y * v0.y) + (v0.z * v0.z + v0.w * v0.w) + (v1.x * v1.x + v1.y * v1.y) + (v1.z * v1.z + v1.w * v1.w); }
                    if (ACT == 1) {
                        v0.x = fmaxf(v0.x, 0.f); v0.y = fmaxf(v0.y, 0.f); v0.z = fmaxf(v0.z, 0.f); v0.w = fmaxf(v0.w, 0.f);
                        v1.x = fmaxf(v1.x, 0.f); v1.y = fmaxf(v1.y, 0.f); v1.z = fmaxf(v1.z, 0.f); v1.w = fmaxf(v1.w, 0.f);
                        v0 = v0 * v0; v1 = v1 * v1; }
                    u32x4 w; w.x = cvt_pk_bf16(v0.x, v0.y); w.y = cvt_pk_bf16(v0.z, v0.w); w.z = cvt_pk_bf16(v1.x, v1.y); w.w = cvt_pk_bf16(v1.z, v1.w);
                    *(u32x4*)(O + (size_t)row * ldc + dcol) = w;
                }
                if (SSMODE == 1) { ssq += __shfl_xor(ssq, 16); ssq += __shfl_xor(ssq, 32); if (fq == 0 && u.pn < 2) ss_out[(size_t)row * 8 + u.pn * 4 + wc] = ssq; }
            }
    }
};
struct EpiConvIn {
    static constexpr bool PERM = true;
    bf16_t* O; const float* ssp; const LAS float* tab; int tab_pm;
    __device__ __forceinline__ void operator()(const f32x4 (&acc)[2][2][4][2], const Unit& u, int wr, int wc, int fr, int fq) const {
        const int row0 = u.pm * BM + wr * 64 + fr, cl = wc * 32 + 8 * fq;
        float rsv[2][4];
#pragma unroll
        for (int ai = 0; ai < 2; ++ai)
#pragma unroll
            for (int m = 0; m < 4; ++m) rsv[ai][m] = (u.pm == tab_pm) ? tab[wr * 64 + fr + ai * HALF + m * 16] : rstd_from(ssp + (size_t)(row0 + ai * HALF + m * 16) * 16, 4, 1.0f / DM);
#pragma unroll
        for (int ai = 0; ai < 2; ++ai)
#pragma unroll
            for (int m = 0; m < 4; ++m) {
                const int row = row0 + ai * HALF + m * 16; const float rs = rsv[ai][m];
                bf16_t* orow = O + (size_t)row * (2 * DM);
                if (u.pn < 4) {
#pragma unroll
                    for (int bj = 0; bj < 2; ++bj) { const f32x4 v0 = acc[ai][bj][m][0] * rs, v1 = acc[ai][bj][m][1] * rs;
                        u32x4 w; w.x = cvt_pk_bf16(v0.x, v0.y); w.y = cvt_pk_bf16(v0.z, v0.w); w.z = cvt_pk_bf16(v1.x, v1.y); w.w = cvt_pk_bf16(v1.z, v1.w);
                        *(u32x4*)(orow + u.pn * BM + bj * HALF + cl) = w; }
                } else {
                    const float r2 = rs * rs;
                    const f32x4 v0 = acc[ai][0][m][0] * acc[ai][1][m][0] * r2, v1 = acc[ai][0][m][1] * acc[ai][1][m][1] * r2;
                    u32x4 w; w.x = cvt_pk_bf16(v0.x, v0.y); w.y = cvt_pk_bf16(v0.z, v0.w); w.z = cvt_pk_bf16(v1.x, v1.y); w.w = cvt_pk_bf16(v1.z, v1.w);
                    *(u32x4*)(orow + DM + (u.pn - 4) * HALF + cl) = w;
                }
            }
    }
};
__device__ __forceinline__ void fill_rstd_tab(LAS float* tab, const float* ssp, int ss_stride, int ss_n4, float inv_dim, int pm, int tid) {
    if (tid < 256) tab[tid] = rstd_from(ssp + (size_t)(pm * BM + tid) * ss_stride, ss_n4, inv_dim);
}
struct EpiVT {
    static constexpr bool PERM = true;
    bf16_t* O; int ldc; const float* ssa;
    __device__ __forceinline__ void operator()(const f32x4 (&acc)[2][2][4][2], const Unit& u, int wr, int wc, int fr, int fq) const {
        const int row0 = u.pm * BM + wr * 64 + fr, colt = u.pn * BM + wc * 32 + 8 * fq;
#pragma unroll
        for (int bj = 0; bj < 2; ++bj) {
            float cs[8];
#pragma unroll
            for (int j = 0; j < 8; ++j) cs[j] = rstd_from(ssa + (size_t)(colt + bj * HALF + j) * 8 + 4, 1, 1.0f / KVLORA);
#pragma unroll
            for (int ai = 0; ai < 2; ++ai)
#pragma unroll
                for (int m = 0; m < 4; ++m) {
                    const int row = row0 + ai * HALF + m * 16;
                    const f32x4 a0 = acc[ai][bj][m][0], a1 = acc[ai][bj][m][1];
                    u32x4 w; w.x = cvt_pk_bf16(a0.x * cs[0], a0.y * cs[1]); w.y = cvt_pk_bf16(a0.z * cs[2], a0.w * cs[3]);
                    w.z = cvt_pk_bf16(a1.x * cs[4], a1.y * cs[5]); w.w = cvt_pk_bf16(a1.z * cs[6], a1.w * cs[7]);
                    *(u32x4*)(O + (size_t)row * ldc + colt + bj * HALF) = w;
                }
            asm volatile("" ::: "memory");
        }
    }
};
template <bool FINAL> struct EpiResid {
    static constexpr bool PERM = true;
    bf16_t* xb; float* xout; float* ssx;
    __device__ __forceinline__ void operator()(const f32x4 (&acc)[2][2][4][2], const Unit& u, int wr, int wc, int fr, int fq) const {
        const int row0 = u.pm * BM + wr * 64 + fr, colt = u.pn * BM + wc * 32 + 8 * fq;
        float ssv[8];
#pragma unroll
        for (int ai = 0; ai < 2; ++ai) {
            u32x4 xv[4][2];
#pragma unroll
            for (int m = 0; m < 4; ++m)
#pragma unroll
                for (int bj = 0; bj < 2; ++bj) xv[m][bj] = *(const u32x4*)(xb + (size_t)(row0 + ai * HALF + m * 16) * DM + colt + bj * HALF);
            asm volatile("" ::: "memory");
#pragma unroll
            for (int m = 0; m < 4; ++m) {
                const int row = row0 + ai * HALF + m * 16; float ssq = 0.f;
#pragma unroll
                for (int bj = 0; bj < 2; ++bj) {
                    const size_t off = (size_t)row * DM + colt + bj * HALF;
                    const u32x4 xw = xv[m][bj];
                    f32x4 v0 = acc[ai][bj][m][0], v1 = acc[ai][bj][m][1];
                    v0.x += bflo(xw.x); v0.y += bfhi(xw.x); v0.z += bflo(xw.y); v0.w += bfhi(xw.y);
                    v1.x += bflo(xw.z); v1.y += bfhi(xw.z); v1.z += bflo(xw.w); v1.w += bfhi(xw.w);
                    if (FINAL) { *(f32x4*)(xout + off) = v0; *(f32x4*)(xout + off + 4) = v1; }
                    else {
                        ssq += (v0.x * v0.x + v0.y * v0.y) + (v0.z * v0.z + v0.w * v0.w) + (v1.x * v1.x + v1.y * v1.y) + (v1.z * v1.z + v1.w * v1.w);
                        u32x4 w; w.x = cvt_pk_bf16(v0.x, v0.y); w.y = cvt_pk_bf16(v0.z, v0.w); w.z = cvt_pk_bf16(v1.x, v1.y); w.w = cvt_pk_bf16(v1.z, v1.w);
                        *(u32x4*)(xb + off) = w;
                    }
                }
                if (!FINAL) { ssq += __shfl_xor(ssq, 16); ssq += __shfl_xor(ssq, 32); ssv[ai * 4 + m] = ssq; }
            }
            asm volatile("" ::: "memory");
        }
        if (!FINAL) {
            const float v0 = (fq == 0) ? ssv[0] : (fq == 1) ? ssv[2] : (fq == 2) ? ssv[4] : ssv[6];
            const float v1 = (fq == 0) ? ssv[1] : (fq == 1) ? ssv[3] : (fq == 2) ? ssv[5] : ssv[7];
            const int g0 = 2 * fq, g1 = 2 * fq + 1;
            ssx[(size_t)(row0 + (g0 >> 2) * HALF + (g0 & 3) * 16) * 16 + u.pn * 4 + wc] = v0;
            ssx[(size_t)(row0 + (g1 >> 2) * HALF + (g1 & 3) * 16) * 16 + u.pn * 4 + wc] = v1;
        }
    }
};

template <class Epi, class Sched, bool ALIGN_EPI>
__device__ __forceinline__ void gemm_phase(LAS unsigned char* lds, const Gemm g, const Sched& S, const Epi& E) {
    int tid = threadIdx.x; asm volatile("" : "+v"(tid));
    const int wid = __builtin_amdgcn_readfirstlane(tid >> 6), lane = tid & 63, wr = wid >> 2, wc = wid & 3, fr = lane & 15, fq = lane >> 4;
    int K = g.K; asm volatile("" : "+s"(K));
    const int nt = K / BK;
    unsigned voffA[2], voffB[2];
#pragma unroll
    for (int i = 0; i < 2; ++i) { int R, C; stage_rc(tid * 16 + i * 8192, R, C); const int Rb = Epi::PERM ? ((R & ~31) + perm32(R & 31)) : R;
        voffA[i] = (unsigned)(R * g.lda + C) * 2u; voffB[i] = (unsigned)(Rb * g.ldb + C) * 2u; }
    const size_t kstep = (size_t)(BK * 2);
    const size_t hstepA = (size_t)HALF * g.lda * 2, hstepB = (size_t)HALF * g.ldb * 2;
    const size_t tstepA = 2 * hstepA, tstepB = 2 * hstepB;
    const unsigned ldsw = (unsigned)wid * 1024u;
    const int aoff = lds_byte(wr * 64 + fr, fq * 8), boff = lds_byte(wc * 32 + fr, fq * 8);
#define PG8_SA(b, h) (((b) * 2 + (h)) * HTB)
#define PG8_SB(b, h) ((4 + (b) * 2 + (h)) * HTB)
#define PG8_STAGE(bufoff, gbase, voff) do { _Pragma("unroll") for (int _i = 0; _i < 2; ++_i) \
        __builtin_amdgcn_global_load_lds((const unsigned*)((const char*)(gbase) + (voff)[_i]), (LAS unsigned*)(lds + (bufoff) + ldsw + _i * 8192), 16, 0, 0); } while (0)
#define PG8_LDA(dst, b, h) do { _Pragma("unroll") for (int m = 0; m < 4; ++m) _Pragma("unroll") for (int k = 0; k < 2; ++k) dst[m][k] = *(const LAS bf16x8*)(lds + PG8_SA(b, h) + aoff + m * 2048 + k * 1024); } while (0)
#define PG8_LDB(dst, b, h) do { _Pragma("unroll") for (int n = 0; n < 2; ++n) _Pragma("unroll") for (int k = 0; k < 2; ++k) dst[n][k] = *(const LAS bf16x8*)(lds + PG8_SB(b, h) + boff + n * 2048 + k * 1024); } while (0)
#define PG8_MMA(ai, bj, At, Bt) do { __builtin_amdgcn_s_setprio(1); _Pragma("unroll") for (int m = 0; m < 4; ++m) _Pragma("unroll") for (int n = 0; n < 2; ++n) _Pragma("unroll") for (int k = 0; k < 2; ++k) \
        acc[ai][bj][m][n] = __builtin_amdgcn_mfma_f32_16x16x32_bf16(Bt[n][k], At[m][k], acc[ai][bj][m][n], 0, 0, 0); __builtin_amdgcn_s_setprio(0); } while (0)
#define PG8_WAIT_V(n) asm volatile("s_waitcnt vmcnt(" #n ")" ::: "memory")
#define PG8_WAIT_L(n) asm volatile("s_waitcnt lgkmcnt(" #n ")" ::: "memory")
#define PG8_BAR __builtin_amdgcn_s_barrier()
#define PG8_SCHED __builtin_amdgcn_sched_barrier(0)
    Unit cur, nxt; int ui = 0;
    if (!S.next(0, cur)) return;
    f32x4 acc[2][2][4][2];
#pragma unroll
    for (int a = 0; a < 2; ++a)
#pragma unroll
        for (int b = 0; b < 2; ++b)
#pragma unroll
            for (int m = 0; m < 4; ++m)
#pragma unroll
                for (int n = 0; n < 2; ++n) acc[a][b][m][n] = (f32x4){0.f, 0.f, 0.f, 0.f};
    bf16x8 At[4][2], B0[2][2], B1[2][2];
    const char* cA = (const char*)g.A + (size_t)cur.pm * tstepA; const char* cB = (const char*)g.Bt + (size_t)cur.pn * tstepB;
    PG8_STAGE(PG8_SB(0, 0), cB, voffB); PG8_STAGE(PG8_SB(0, 1), cB + hstepB, voffB); PG8_STAGE(PG8_SA(0, 0), cA, voffA); PG8_STAGE(PG8_SA(0, 1), cA + hstepA, voffA);
    if (wr == 1) PG8_BAR;
    PG8_WAIT_V(2); PG8_BAR;
    PG8_STAGE(PG8_SB(1, 0), cB + kstep, voffB); PG8_STAGE(PG8_SA(1, 0), cA + kstep, voffA); PG8_STAGE(PG8_SB(1, 1), cB + hstepB + kstep, voffB);
    PG8_WAIT_V(6); PG8_BAR;
    for (;;) {
        const bool has_next = S.next(ui + 1, nxt);
        const char* nA = has_next ? (const char*)g.A + (size_t)nxt.pm * tstepA : cA; const char* nB = has_next ? (const char*)g.Bt + (size_t)nxt.pn * tstepB : cB;
        for (int t = 0; t < nt; t += 2) {
            const bool last = (t == nt - 2);
            const char* a1 = cA + (size_t)(t + 1) * kstep;
            const char* a2 = last ? nA : cA + (size_t)(t + 2) * kstep; const char* b2 = last ? nB : cB + (size_t)(t + 2) * kstep;
            const char* a3 = a2 + kstep; const char* b3 = b2 + kstep;
            PG8_LDB(B0, 0, 0); PG8_LDB(B1, 0, 1); PG8_SCHED; PG8_LDA(At, 0, 0); PG8_STAGE(PG8_SA(1, 1), a1 + hstepA, voffA);
            PG8_WAIT_V(8); PG8_WAIT_L(0); PG8_BAR; PG8_MMA(0, 0, At, B0); PG8_MMA(0, 1, At, B1); PG8_BAR; PG8_SCHED;
            PG8_LDA(At, 0, 1); PG8_STAGE(PG8_SB(0, 0), b2, voffB); PG8_STAGE(PG8_SB(0, 1), b2 + hstepB, voffB); PG8_STAGE(PG8_SA(0, 0), a2, voffA);
            PG8_WAIT_V(8); PG8_WAIT_L(0); PG8_BAR; PG8_MMA(1, 0, At, B0); PG8_MMA(1, 1, At, B1); PG8_BAR; PG8_SCHED;
            PG8_LDB(B0, 1, 0); PG8_LDB(B1, 1, 1); PG8_SCHED; PG8_LDA(At, 1, 0); PG8_STAGE(PG8_SA(0, 1), a2 + hstepA, voffA);
            PG8_WAIT_V(8); PG8_WAIT_L(0); PG8_BAR; PG8_MMA(0, 0, At, B0); PG8_MMA(0, 1, At, B1); PG8_BAR; PG8_SCHED;
            PG8_LDA(At, 1, 1); PG8_STAGE(PG8_SB(1, 0), b3, voffB); PG8_STAGE(PG8_SB(1, 1), b3 + hstepB, voffB); PG8_STAGE(PG8_SA(1, 0), a3, voffA);
            PG8_WAIT_V(8); PG8_WAIT_L(0); PG8_BAR; PG8_MMA(1, 0, At, B0); PG8_MMA(1, 1, At, B1); PG8_BAR; PG8_SCHED;
        }
        if constexpr (ALIGN_EPI) { if (wr == 0) PG8_BAR; }
        E(acc, cur, wr, wc, fr, fq);
        if (!has_next) break;
#pragma unroll
        for (int a = 0; a < 2; ++a)
#pragma unroll
            for (int b = 0; b < 2; ++b)
#pragma unroll
                for (int m = 0; m < 4; ++m)
#pragma unroll
                    for (int n = 0; n < 2; ++n) acc[a][b][m][n] = (f32x4){0.f, 0.f, 0.f, 0.f};
        cur = nxt; cA = nA; cB = nB; ++ui;
        if constexpr (ALIGN_EPI) { if (wr == 1) PG8_BAR; }
    }
    PG8_WAIT_V(0);
    if constexpr (!ALIGN_EPI) { if (wr == 0) PG8_BAR; }
    PG8_BAR;
#undef PG8_SA
#undef PG8_SB
#undef PG8_STAGE
#undef PG8_LDA
#undef PG8_LDB
#undef PG8_MMA
#undef PG8_WAIT_V
#undef PG8_WAIT_L
#undef PG8_BAR
#undef PG8_SCHED
}
}

namespace att2 {
constexpr int KBUF = 64 * 384, VBUF = 128 * 128;
constexpr int L_K = 0, L_V = 2 * KBUF, L_WS = L_V + 2 * VBUF, L_END = L_WS + 8 * 128;
constexpr float THR = 8.0f;
typedef float f32x2_t __attribute__((ext_vector_type(2))); typedef __bf16 bf16x2_t __attribute__((ext_vector_type(2)));
__device__ __forceinline__ unsigned cvtpk(float lo, float hi) { f32x2_t v = {lo, hi}; bf16x2_t b = __builtin_convertvector(v, bf16x2_t); return __builtin_bit_cast(unsigned, b); }
__device__ __forceinline__ int kperm(int r) { return (r & ~12) | ((r & 4) << 1) | ((r & 8) >> 1); }
#define SGB(m, n) __builtin_amdgcn_sched_group_barrier(m, n, 0)
__device__ __forceinline__ float rowmax32(const f32x16& a, const f32x16& b) {
    float x = __builtin_fmaxf(__builtin_fmaxf(a[0], a[1]), b[0]), y = __builtin_fmaxf(__builtin_fmaxf(a[2], a[3]), b[1]);
    x = __builtin_fmaxf(__builtin_fmaxf(x, b[2]), b[3]);
#pragma unroll
    for (int r = 4; r < 16; r += 4) { x = __builtin_fmaxf(__builtin_fmaxf(x, a[r]), a[r + 1]); y = __builtin_fmaxf(__builtin_fmaxf(y, a[r + 2]), a[r + 3]);
        x = __builtin_fmaxf(__builtin_fmaxf(x, b[r]), b[r + 1]); y = __builtin_fmaxf(__builtin_fmaxf(y, b[r + 2]), b[r + 3]); }
    return __builtin_fmaxf(x, y);
}
__device__ __forceinline__ float xhalf_max(float m) { auto rr = __builtin_amdgcn_permlane32_swap(__float_as_uint(m), __float_as_uint(m), false, false); return __builtin_fmaxf(__uint_as_float(rr[0]), __uint_as_float(rr[1])); }

__device__ __forceinline__ void attn_unit(LAS unsigned char* lds, int b, int h, int qb, const bf16_t* __restrict__ Q, const bf16_t* __restrict__ Kg, const bf16_t* __restrict__ VT, bf16_t* __restrict__ O, const float* __restrict__ gq, const float* __restrict__ rope) {
    int tid = threadIdx.x; asm volatile("" : "+v"(tid));
    const int lane = tid & 63, r32 = lane & 31, hh = lane >> 5; const int wid = __builtin_amdgcn_readfirstlane(tid >> 6);
    const int q0 = qb * 256, q0w = q0 + wid * 32;
    const size_t tokb = (size_t)b * SEQ;
    const int NT = (q0 + 256) / 64;
    const int my_last = (q0w + 31) / 64;
    unsigned kgo[3], vgo[2];
#pragma unroll
    for (int i = 0; i < 3; ++i) { const int slot = (wid * 3 + i) * 64 + lane, row = slot / 24, cc = slot % 24, c = (cc & ~7) | ((cc & 7) ^ ((row >> 1) & 7)); kgo[i] = (unsigned)(row * QW + c * 8) * 2u; }
#pragma unroll
    for (int i = 0; i < 2; ++i) { const int slot = (wid * 2 + i) * 64 + lane, d = slot >> 3, cc = slot & 7, c = cc ^ ((d >> 1) & 7); vgo[i] = (unsigned)(d * MT + c * 8) * 2u; }
    const char* kbase = (const char*)(Kg + tokb * QW + h * DQK);
    const char* vbase = (const char*)(VT + (size_t)(h * DV) * MT + tokb);
#define A2_DMA_K(t, buf) do { _Pragma("unroll") for (int i = 0; i < 3; ++i) __builtin_amdgcn_global_load_lds((const unsigned*)(kbase + (size_t)(t) * (64 * QW * 2) + kgo[i]), \
        (LAS unsigned*)(lds + L_K + (buf) * KBUF + (wid * 3 + i) * 1024), 16, 0, 0); } while (0)
#define A2_DMA_V(t, buf) do { _Pragma("unroll") for (int i = 0; i < 2; ++i) __builtin_amdgcn_global_load_lds((const unsigned*)(vbase + (size_t)(t) * 128 + vgo[i]), \
        (LAS unsigned*)(lds + L_V + (buf) * VBUF + (wid * 2 + i) * 1024), 16, 0, 0); } while (0)
    A2_DMA_K(0, 0); A2_DMA_V(0, 0); if (NT > 1) A2_DMA_K(1, 1);
    bf16x8 qf[12];
    { const bf16_t* qp = Q + (tokb + q0w + r32) * QW + h * DQK + hh * 8;
#pragma unroll
      for (int st = 0; st < 12; ++st) qf[st] = *(const bf16x8*)(qp + st * 16);
      float ss = 0.f;
#pragma unroll
      for (int st = 0; st < 12; ++st) { const u32x4 w = __builtin_bit_cast(u32x4, qf[st]);
          ss += bflo(w.x) * bflo(w.x) + bfhi(w.x) * bfhi(w.x) + bflo(w.y) * bflo(w.y) + bfhi(w.y) * bfhi(w.y) + bflo(w.z) * bflo(w.z) + bfhi(w.z) * bfhi(w.z) + bflo(w.w) * bflo(w.w) + bfhi(w.w) * bfhi(w.w); }
      { auto rr = __builtin_amdgcn_permlane32_swap(__float_as_uint(ss), __float_as_uint(ss), false, false); ss = __uint_as_float(rr[0]) + __uint_as_float(rr[1]); }
      const float rs = rsqrtf(ss * (1.0f / DQK) + EPS) * QSCALE;
      const float* gp = gq + 8 * hh;
      const float* rp = rope + (tokb + q0w + r32) * 64 + 8 * hh;
#pragma unroll
      for (int st = 0; st < 8; ++st) { const u32x4 w = __builtin_bit_cast(u32x4, qf[st]);
          u32x4 o; o.x = cvtpk(bflo(w.x) * rs, bfhi(w.x) * rs); o.y = cvtpk(bflo(w.y) * rs, bfhi(w.y) * rs);
          o.z = cvtpk(bflo(w.z) * rs, bfhi(w.z) * rs); o.w = cvtpk(bflo(w.w) * rs, bfhi(w.w) * rs);
          qf[st] = __builtin_bit_cast(bf16x8, o); }
#pragma unroll
      for (int st = 8; st < 10; ++st) {
          const u32x4 w1 = __builtin_bit_cast(u32x4, qf[st]), w2 = __builtin_bit_cast(u32x4, qf[st + 2]);
          const f32x4 ga0 = *(const f32x4*)(gp + 16 * st), ga1 = *(const f32x4*)(gp + 16 * st + 4), gb0 = *(const f32x4*)(gp + 16 * st + 32), gb1 = *(const f32x4*)(gp + 16 * st + 36);
          const f32x4 c0 = *(const f32x4*)(rp + 16 * (st - 8)), c1 = *(const f32x4*)(rp + 16 * (st - 8) + 4), s0 = *(const f32x4*)(rp + 32 + 16 * (st - 8)), s1 = *(const f32x4*)(rp + 32 + 16 * (st - 8) + 4);
          float x1[8], x2[8], cs[8], sn[8];
          x1[0] = bflo(w1.x) * rs * ga0.x; x1[1] = bfhi(w1.x) * rs * ga0.y; x1[2] = bflo(w1.y) * rs * ga0.z; x1[3] = bfhi(w1.y) * rs * ga0.w;
          x1[4] = bflo(w1.z) * rs * ga1.x; x1[5] = bfhi(w1.z) * rs * ga1.y; x1[6] = bflo(w1.w) * rs * ga1.z; x1[7] = bfhi(w1.w) * rs * ga1.w;
          x2[0] = bflo(w2.x) * rs * gb0.x; x2[1] = bfhi(w2.x) * rs * gb0.y; x2[2] = bflo(w2.y) * rs * gb0.z; x2[3] = bfhi(w2.y) * rs * gb0.w;
          x2[4] = bflo(w2.z) * rs * gb1.x; x2[5] = bfhi(w2.z) * rs * gb1.y; x2[6] = bflo(w2.w) * rs * gb1.z; x2[7] = bfhi(w2.w) * rs * gb1.w;
          cs[0] = c0.x; cs[1] = c0.y; cs[2] = c0.z; cs[3] = c0.w; cs[4] = c1.x; cs[5] = c1.y; cs[6] = c1.z; cs[7] = c1.w;
          sn[0] = s0.x; sn[1] = s0.y; sn[2] = s0.z; sn[3] = s0.w; sn[4] = s1.x; sn[5] = s1.y; sn[6] = s1.z; sn[7] = s1.w;
          float y1[8], y2[8];
#pragma unroll
          for (int i = 0; i < 8; ++i) { y1[i] = x1[i] * cs[i] - x2[i] * sn[i]; y2[i] = x2[i] * cs[i] + x1[i] * sn[i]; }
          u32x4 o1, o2; o1.x = cvtpk(y1[0], y1[1]); o1.y = cvtpk(y1[2], y1[3]); o1.z = cvtpk(y1[4], y1[5]); o1.w = cvtpk(y1[6], y1[7]);
          o2.x = cvtpk(y2[0], y2[1]); o2.y = cvtpk(y2[2], y2[3]); o2.z = cvtpk(y2[4], y2[5]); o2.w = cvtpk(y2[6], y2[7]);
          qf[st] = __builtin_bit_cast(bf16x8, o1); qf[st + 2] = __builtin_bit_cast(bf16x8, o2); }
    }
    __builtin_amdgcn_sched_barrier(0);
    int ka[4], va[4];
    { const int row = kperm(r32), g = (row >> 1) & 7;
#pragma unroll
      for (int j = 0; j < 4; ++j) ka[j] = L_K + row * 384 + (((2 * j + hh) ^ g) * 16);
      const int gv = (r32 >> 1) & 7;
#pragma unroll
      for (int sI = 0; sI < 4; ++sI) va[sI] = L_V + r32 * 128 + (((2 * sI + hh) ^ gv) * 16); }
#define A2_KF(buf, st, half) (*(const LAS bf16x8*)(lds + ka[(st) & 3] + (buf) * KBUF + ((st) >> 2) * 128 + (half) * (32 * 384)))
#define A2_VF(buf, db, sI) (*(const LAS bf16x8*)(lds + va[sI] + (buf) * VBUF + (db) * (32 * 128)))
    f32x16 o[4];
#pragma unroll
    for (int d = 0; d < 4; ++d)
#pragma unroll
        for (int r = 0; r < 16; ++r) o[d][r] = 0.f;
    float m_run = 0.f, l_run = 0.f;
    f32x16 negm;
#pragma unroll
    for (int r = 0; r < 16; ++r) negm[r] = 0.f;
    LAS float* wsf = (LAS float*)(lds + L_WS + wid * 128);
    asm volatile("s_waitcnt vmcnt(0)" ::: "memory");
    __syncthreads();
    if (wid >= 4) __builtin_amdgcn_s_setprio(1);
    f32x16 s0, s1;
    { s0 = negm; s1 = negm;
#pragma unroll
      for (int st = 0; st < 12; ++st) { s0 = __builtin_amdgcn_mfma_f32_32x32x16_bf16(A2_KF(0, st, 0), qf[st], s0, 0, 0, 0); s1 = __builtin_amdgcn_mfma_f32_32x32x16_bf16(A2_KF(0, st, 1), qf[st], s1, 0, 0, 0); }
      if (63 > q0w) { const int qi = q0w + r32, kv0 = 8 * hh;
#pragma unroll
          for (int r = 0; r < 16; ++r) { const int kv = kv0 + (r & 7) + 16 * (r >> 3); if (kv > qi) s0[r] = -1e30f; if (kv + 32 > qi) s1[r] = -1e30f; } }
      const float rm = xhalf_max(rowmax32(s0, s1));
      m_run = rm;
#pragma unroll
      for (int r = 0; r < 16; ++r) { s0[r] -= rm; s1[r] -= rm; negm[r] = -rm; }
    }
    asm volatile("s_waitcnt lgkmcnt(0)" ::: "memory");
    __builtin_amdgcn_s_barrier();
    asm volatile("" ::: "memory");
    for (int t = 0; t < NT; ++t) {
        const int cb = t & 1, nb = cb ^ 1;
        if (t + 2 < NT) A2_DMA_K(t + 2, cb);
        if (t + 1 < NT) A2_DMA_V(t + 1, nb);
        if (t <= my_last) {
            const bool has_next = (t + 1 <= my_last);
            f32x16 n0 = negm, n1 = negm;
            bf16x8 pf[4];
            float ls = 0.f;
            if (has_next) {
#pragma unroll
                for (int st = 0; st < 12; ++st) { n0 = __builtin_amdgcn_mfma_f32_32x32x16_bf16(A2_KF(nb, st, 0), qf[st], n0, 0, 0, 0); n1 = __builtin_amdgcn_mfma_f32_32x32x16_bf16(A2_KF(nb, st, 1), qf[st], n1, 0, 0, 0); }
            }
#pragma unroll
            for (int r = 0; r < 16; ++r) { s0[r] = __builtin_amdgcn_exp2f(s0[r]); s1[r] = __builtin_amdgcn_exp2f(s1[r]); }
#pragma unroll
            for (int r = 0; r < 16; ++r) ls += s0[r] + s1[r];
#pragma unroll
            for (int sI = 0; sI < 4; ++sI) { u32x4 w;
                if (sI < 2) { w.x = cvtpk(s0[8 * sI + 0], s0[8 * sI + 1]); w.y = cvtpk(s0[8 * sI + 2], s0[8 * sI + 3]); w.z = cvtpk(s0[8 * sI + 4], s0[8 * sI + 5]); w.w = cvtpk(s0[8 * sI + 6], s0[8 * sI + 7]); }
                else { const int s2 = sI - 2; w.x = cvtpk(s1[8 * s2 + 0], s1[8 * s2 + 1]); w.y = cvtpk(s1[8 * s2 + 2], s1[8 * s2 + 3]); w.z = cvtpk(s1[8 * s2 + 4], s1[8 * s2 + 5]); w.w = cvtpk(s1[8 * s2 + 6], s1[8 * s2 + 7]); }
                pf[sI] = __builtin_bit_cast(bf16x8, w); }
            l_run += ls;
            if (has_next) {
                SGB(0x100, 4);
#pragma unroll
                for (int i = 0; i < 20; ++i) { SGB(0x008, 1); SGB(0x100, 1); SGB(0x002, 4); }
#pragma unroll
                for (int i = 0; i < 4; ++i) { SGB(0x008, 1); SGB(0x002, 4); }
                __builtin_amdgcn_sched_barrier(0);
                if ((t + 1) * 64 + 63 > q0w) { const int qi = q0w + r32, kv0 = (t + 1) * 64 + 8 * hh;
#pragma unroll
                    for (int r = 0; r < 16; ++r) { const int kv = kv0 + (r & 7) + 16 * (r >> 3); if (kv > qi) n0[r] = -1e30f; if (kv + 32 > qi) n1[r] = -1e30f; } }
                __builtin_amdgcn_sched_barrier(0);
            }
#pragma unroll
            for (int sI = 0; sI < 4; ++sI)
#pragma unroll
                for (int d = 0; d < 4; ++d) o[d] = __builtin_amdgcn_mfma_f32_32x32x16_bf16(pf[sI], A2_VF(cb, d, sI), o[d], 0, 0, 0);
            float rm = -1e30f;
            if (has_next) rm = xhalf_max(rowmax32(n0, n1));
            SGB(0x100, 4);
#pragma unroll
            for (int i = 0; i < 12; ++i) { SGB(0x008, 1); SGB(0x100, 1); SGB(0x002, 2); }
#pragma unroll
            for (int i = 0; i < 4; ++i) { SGB(0x008, 1); SGB(0x002, 2); }
            __builtin_amdgcn_sched_barrier(0);
            if (__any(rm > THR)) {
                const float dl = __builtin_fmaxf(rm, 0.f), al = __builtin_amdgcn_exp2f(-dl);
                m_run += dl; l_run *= al;
#pragma unroll
                for (int r = 0; r < 16; ++r) { n0[r] -= dl; n1[r] -= dl; negm[r] = -m_run; }
                if (hh == 0) wsf[r32] = al;
                asm volatile("s_waitcnt lgkmcnt(0)" ::: "memory");
#pragma unroll
                for (int g = 0; g < 4; ++g) { const f32x4 a4 = *(const LAS f32x4*)(wsf + 8 * g + 4 * hh);
#pragma unroll
                    for (int d = 0; d < 4; ++d) { o[d][4 * g + 0] *= a4.x; o[d][4 * g + 1] *= a4.y; o[d][4 * g + 2] *= a4.z; o[d][4 * g + 3] *= a4.w; } }
                asm volatile("s_waitcnt lgkmcnt(0)" ::: "memory");
            }
            s0 = n0; s1 = n1;
        }
        asm volatile("s_waitcnt vmcnt(0) lgkmcnt(0)" ::: "memory");
        __builtin_amdgcn_s_barrier();
        asm volatile("" ::: "memory");
    }
    __builtin_amdgcn_s_setprio(0);
    l_run += __shfl_xor(l_run, 32);
    if (hh == 0) wsf[r32] = 1.0f / l_run;
    asm volatile("s_waitcnt lgkmcnt(0)" ::: "memory");
    LAS bf16_t* stg = (LAS bf16_t*)(lds + wid * 8192);
#pragma unroll
    for (int g = 0; g < 4; ++g) { const f32x4 a4 = *(const LAS f32x4*)(wsf + 8 * g + 4 * hh);
#pragma unroll
        for (int i = 0; i < 4; ++i) { const int row = 8 * g + 4 * hh + i; const float sc = (i == 0) ? a4.x : (i == 1) ? a4.y : (i == 2) ? a4.z : a4.w;
#pragma unroll
            for (int d = 0; d < 4; ++d) stg[row * 128 + d * 32 + r32] = (bf16_t)f2bf(o[d][4 * g + i] * sc); } }
    asm volatile("s_waitcnt lgkmcnt(0)" ::: "memory");
    { bf16_t* ob = O + (tokb + q0w) * DM + h * DV;
#pragma unroll
      for (int k = 0; k < 8; ++k) { const int chunk = k * 64 + lane, row = chunk >> 4, c16 = chunk & 15;
          const u32x4 v = *(const LAS u32x4*)(stg + row * 128 + c16 * 8); *(u32x4*)(ob + (size_t)row * DM + c16 * 8) = v; } }
    asm volatile("s_waitcnt lgkmcnt(0)" ::: "memory");
    __builtin_amdgcn_s_barrier();
    asm volatile("" ::: "memory");
#undef A2_DMA_K
#undef A2_DMA_V
#undef A2_KF
#undef A2_VF
}
__device__ __forceinline__ void attn_phase(LAS unsigned char* lds, int vcu, int G, const bf16_t* Q, const bf16_t* Kg, const bf16_t* VT, bf16_t* O, const float* gq, const float* rope) {
    for (int p = vcu; p < 256; p += G) {
        const int bh = p >> 4, s = p & 15;
        attn_unit(lds, bh >> 3, bh & 7, 31 - s, Q, Kg, VT, O, gq, rope);
        attn_unit(lds, bh >> 3, bh & 7, s, Q, Kg, VT, O, gq, rope);
    }
}
#undef SGB
}

__device__ __forceinline__ void transpose_item(const float* __restrict__ W, int N, int k0, int n0, bf16_t* dst, int ldk, const float* __restrict__ gain, LAS float* scr, int lane) {
    f32x4 v[8]; float gv[8];
#pragma unroll
    for (int i = 0; i < 8; ++i) { const int kk = 8 * i + (lane >> 3); v[i] = *(const f32x4*)(W + (size_t)(k0 + kk) * N + n0 + (lane & 7) * 4); gv[i] = gain ? gain[k0 + kk] : 1.0f; }
#pragma unroll
    for (int i = 0; i < 8; ++i) { const int kk = 8 * i + (lane >> 3); LAS float* p = scr + kk * 33 + (lane & 7) * 4; p[0] = v[i].x * gv[i]; p[1] = v[i].y * gv[i]; p[2] = v[i].z * gv[i]; p[3] = v[i].w * gv[i]; }
    asm volatile("s_waitcnt lgkmcnt(0)" ::: "memory");
    const int c = lane & 7;
#pragma unroll
    for (int j = 0; j < 4; ++j) { const int n = (lane >> 3) + 8 * j; const LAS float* s = scr + (8 * c) * 33 + n;
        u32x4 o; o.x = pk2(s[0 * 33], s[1 * 33]); o.y = pk2(s[2 * 33], s[3 * 33]); o.z = pk2(s[4 * 33], s[5 * 33]); o.w = pk2(s[6 * 33], s[7 * 33]);
        *(u32x4*)(dst + (size_t)n * ldk + k0 + 8 * c) = o; }
    asm volatile("s_waitcnt lgkmcnt(0)" ::: "memory");
}
struct In {
    const float* x; const int* pos; const float *g_mix, *g_mlp, *w_down, *g_q_a, *g_kv_a, *w_uq, *w_ukv, *g_qn, *g_kn, *w_o, *c_w_in, *c_w, *c_w_out, *w1, *w2;
};
struct MlaW { bf16_t *wd, *wuq, *wuk, *wuvt, *wo; };
struct ConvW { bf16_t *win, *wout; };
__device__ __forceinline__ MlaW mla_w(unsigned char* ws, int j) { MlaW w; bf16_t* p = (bf16_t*)(ws + WS_WMIX + (size_t)j * WMLA_BYTES);
    w.wd = p; p += DOWNP * DM; w.wuq = p; p += QW * QLORA; w.wuk = p; p += 1024 * KVLORA; w.wuvt = p; p += 1024 * KVLORA; w.wo = p; return w; }
__device__ __forceinline__ ConvW conv_w(unsigned char* ws, int j) { ConvW w; bf16_t* p = (bf16_t*)(ws + WS_WCONV + (size_t)j * WCONV_BYTES); w.win = p; w.wout = p + 3 * DM * DM; return w; }

__device__ __forceinline__ void convert_mlp(const In& in, unsigned char* ws, int L, LAS float* scr, int gw, int NGW, int lane) {
    bf16_t* w1t = (bf16_t*)(ws + WS_WMLP); bf16_t* w2t = w1t + (size_t)FF * DM;
    const float* w1 = in.w1 + (size_t)L * DM * FF; const float* w2 = in.w2 + (size_t)L * FF * DM; const float* g = in.g_mlp + L * DM;
    constexpr int I1 = (DM / 64) * (FF / 32), I2 = (FF / 64) * (DM / 32);
    for (int it = gw; it < I1 + I2; it += NGW) {
        if (it < I1) { const int kb = it / (FF / 32), nb = it % (FF / 32); transpose_item(w1, FF, kb * 64, nb * 32, w1t + (size_t)(nb * 32) * DM, DM, g, scr, lane); }
        else { const int r = it - I1, kb = r / (DM / 32), nb = r % (DM / 32); transpose_item(w2, DM, kb * 64, nb * 32, w2t + (size_t)(nb * 32) * FF, FF, nullptr, scr, lane); }
    }
}
__device__ __forceinline__ void convert_conv(const In& in, unsigned char* ws, int j, LAS float* scr, int gw, int NGW, int lane) {
    constexpr int I_IN = (DM / 64) * (3 * DM / 32), I_OUT = (DM / 64) * (DM / 32);
    const ConvW w = conv_w(ws, j);
    for (int r = gw; r < I_IN + I_OUT; r += NGW) {
        if (r < I_IN) { const int kb = r / (3 * DM / 32), nb = r % (3 * DM / 32), n0 = nb * 32;
            const int part = n0 >> 10, ch0 = n0 & 1023, drow = (part == 0) ? n0 : (1024 + (ch0 >> 7) * 256 + (part - 1) * 128 + (ch0 & 127));
            transpose_item(in.c_w_in + (size_t)j * DM * 3 * DM, 3 * DM, kb * 64, n0, w.win + (size_t)drow * DM, DM, in.g_mix + (2 * j + 1) * DM, scr, lane); }
        else { const int q = r - I_IN, kb = q / (DM / 32), nb = q % (DM / 32); transpose_item(in.c_w_out + (size_t)j * DM * DM, DM, kb * 64, nb * 32, w.wout + (size_t)(nb * 32) * DM, DM, nullptr, scr, lane); }
    }
}
__device__ __forceinline__ void prologue(const In& in, unsigned char* ws, LAS unsigned char* lds, int vcu, int G, int tid) {
    const int lane = tid & 63, wave = tid >> 6, gw = vcu * 8 + wave, NGW = G * 8;
    LAS float* scr = (LAS float*)(lds + wave * 16384);
    constexpr int I_D = (DM / 64) * (DOWN / 32), I_Q = (QLORA / 64) * (QW / 32), I_KV = (KVLORA / 64) * (2048 / 32), I_O = (DM / 64) * (DM / 32);
    constexpr int I_MLA = I_D + I_Q + I_KV + I_O;
    constexpr int I_IN = (DM / 64) * (3 * DM / 32), I_OUT = I_O, I_CONV = I_IN + I_OUT;
    for (int it = gw; it < 2 * I_MLA; it += NGW) {
        const int j = it / I_MLA; int r = it % I_MLA; const MlaW w = mla_w(ws, j);
        if (r < I_D) { const int kb = r / (DOWN / 32), nb = r % (DOWN / 32); transpose_item(in.w_down + (size_t)j * DM * DOWN, DOWN, kb * 64, nb * 32, w.wd + (size_t)(nb * 32) * DM, DM, in.g_mix + (2 * j) * DM, scr, lane); continue; } r -= I_D;
        if (r < I_Q) { const int kb = r / (QW / 32), nb = r % (QW / 32); transpose_item(in.w_uq + (size_t)j * QLORA * QW, QW, kb * 64, nb * 32, w.wuq + (size_t)(nb * 32) * QLORA, QLORA, in.g_q_a + j * QLORA, scr, lane); continue; } r -= I_Q;
        if (r < I_KV) { const int kb = r / 64, nb = r % 64, n0 = nb * 32, hd = n0 >> 8, j0 = n0 & 255;
            bf16_t* dst = (j0 < 128) ? (w.wuk + (size_t)(hd * 128 + j0) * KVLORA) : (w.wuvt + (size_t)(hd * 128 + j0 - 128) * KVLORA);
            transpose_item(in.w_ukv + (size_t)j * KVLORA * 2048, 2048, kb * 64, n0, dst, KVLORA, in.g_kv_a + j * KVLORA, scr, lane); continue; } r -= I_KV;
        { const int kb = r / (DM / 32), nb = r % (DM / 32); transpose_item(in.w_o + (size_t)j * DM * DM, DM, kb * 64, nb * 32, w.wo + (size_t)(nb * 32) * DM, DM, nullptr, scr, lane); }
    }
    { const int gt = vcu * 512 + tid, NT = G * 512;
      for (int i = gt; i < 2 * (DOWNP - DOWN) * DM / 8; i += NT) { const int j = i / ((DOWNP - DOWN) * DM / 8), r = i % ((DOWNP - DOWN) * DM / 8);
          *(u32x4*)(mla_w(ws, j).wd + (size_t)DOWN * DM + (size_t)r * 8) = (u32x4){0u, 0u, 0u, 0u}; }
      float* rope = (float*)(ws + WS_ROPE);
      for (int i = gt; i < MT * 32; i += NT) { const int tok = i >> 5, f = i & 31;
          const float inv = (float)exp2(-(double)f * (13.287712379549449 / 32.0));
          const float ang = (float)in.pos[tok] * inv;
          float sn_, cs_; sincosf(ang, &sn_, &cs_);
          rope[(size_t)tok * 64 + f] = cs_; rope[(size_t)tok * 64 + 32 + f] = sn_; }
    }
    bf16_t* xb = (bf16_t*)(ws + WS_XA); float* ssx = (float*)(ws + WS_SSX);
    for (int m = gw; m < MT; m += 2 * NGW) {
        const int m2 = m + NGW; const bool has2 = m2 < MT;
        const f32x4* xr = (const f32x4*)(in.x + (size_t)m * DM) + lane; const f32x4* xr2 = (const f32x4*)(in.x + (size_t)(has2 ? m2 : m) * DM) + lane;
        f32x4 va[4], vb[4];
#pragma unroll
        for (int j = 0; j < 4; ++j) { va[j] = xr[64 * j]; vb[j] = xr2[64 * j]; }
        float s = 0.f, s2 = 0.f;
        unsigned long long* o8 = (unsigned long long*)(xb + (size_t)m * DM) + lane; unsigned long long* o82 = (unsigned long long*)(xb + (size_t)m2 * DM) + lane;
#pragma unroll
        for (int j = 0; j < 4; ++j) { const f32x4 v = va[j]; s += (v.x * v.x + v.y * v.y) + (v.z * v.z + v.w * v.w);
            o8[64 * j] = (unsigned long long)pk2(v.x, v.y) | ((unsigned long long)pk2(v.z, v.w) << 32); }
        if (has2) {
#pragma unroll
            for (int j = 0; j < 4; ++j) { const f32x4 v = vb[j]; s2 += (v.x * v.x + v.y * v.y) + (v.z * v.z + v.w * v.w);
                o82[64 * j] = (unsigned long long)pk2(v.x, v.y) | ((unsigned long long)pk2(v.z, v.w) << 32); }
        }
        s = wave_sum(s); s2 = wave_sum(s2);
        if (lane < 16) { ssx[(size_t)m * 16 + lane] = (lane == 0) ? s : 0.f; if (has2) ssx[(size_t)m2 * 16 + lane] = (lane == 0) ? s2 : 0.f; }
    }
}
__device__ __forceinline__ void qk_head24(u32x4& c0, u32x4& c1, u32x4& c2, const float (&g)[24], const float (&cs)[8], const float (&sn)[8], int s, float osc) {
    float e[24];
    e[0] = bflo(c0.x); e[1] = bfhi(c0.x); e[2] = bflo(c0.y); e[3] = bfhi(c0.y); e[4] = bflo(c0.z); e[5] = bfhi(c0.z); e[6] = bflo(c0.w); e[7] = bfhi(c0.w);
    e[8] = bflo(c1.x); e[9] = bfhi(c1.x); e[10] = bflo(c1.y); e[11] = bfhi(c1.y); e[12] = bflo(c1.z); e[13] = bfhi(c1.z); e[14] = bflo(c1.w); e[15] = bfhi(c1.w);
    e[16] = bflo(c2.x); e[17] = bfhi(c2.x); e[18] = bflo(c2.y); e[19] = bfhi(c2.y); e[20] = bflo(c2.z); e[21] = bfhi(c2.z); e[22] = bflo(c2.w); e[23] = bfhi(c2.w);
    float ss = 0.f;
#pragma unroll
    for (int i = 0; i < 24; ++i) ss += e[i] * e[i];
    ss += __shfl_xor(ss, 1); ss += __shfl_xor(ss, 2); ss += __shfl_xor(ss, 4);
    const float rs = rsqrtf(ss * (1.0f / DQK) + EPS);
#pragma unroll
    for (int i = 0; i < 24; ++i) e[i] = e[i] * rs * g[i];
#pragma unroll
    for (int i = 0; i < 8; ++i) { const float pr = __shfl_xor(e[16 + i], 4); e[16 + i] = (s < 4) ? (e[16 + i] * cs[i] - pr * sn[i]) : (e[16 + i] * cs[i] + pr * sn[i]); }
#pragma unroll
    for (int i = 0; i < 24; ++i) e[i] *= osc;
    c0.x = pk2(e[0], e[1]); c0.y = pk2(e[2], e[3]); c0.z = pk2(e[4], e[5]); c0.w = pk2(e[6], e[7]);
    c1.x = pk2(e[8], e[9]); c1.y = pk2(e[10], e[11]); c1.z = pk2(e[12], e[13]); c1.w = pk2(e[14], e[15]);
    c2.x = pk2(e[16], e[17]); c2.y = pk2(e[18], e[19]); c2.z = pk2(e[20], e[21]); c2.w = pk2(e[22], e[23]);
}
__device__ __forceinline__ void knorm_unit(const float* __restrict__ gk, const float* __restrict__ gq, const float* __restrict__ rope, bf16_t* kb, const bf16_t* __restrict__ a, int pm, int pn, int tid) {
    const int lane = tid & 63, wave = tid >> 6, slot = lane >> 3, s = lane & 7;
    float gkv[24];
#pragma unroll
    for (int c = 0; c < 3; ++c)
#pragma unroll
        for (int i = 0; i < 8; ++i) gkv[8 * c + i] = gk[64 * c + 8 * s + i] * (c < 2 ? gq[64 * c + 8 * s + i] : 1.0f);
#pragma unroll 1
    for (int bt = 0; bt < 2; ++bt) {
        u32x4 k0[4], k1[4], k2[4]; f32x4 rc[4][2], rsn[4][2];
#pragma unroll
        for (int q4 = 0; q4 < 4; ++q4) { const int it = bt * 4 + q4, tok = pm * 256 + wave * 32 + it * 4 + (slot >> 1), hd = 2 * pn + (slot & 1);
            const bf16_t* kr = kb + (size_t)tok * QW + hd * DQK + 8 * s;
            k0[q4] = *(const u32x4*)(kr); k1[q4] = *(const u32x4*)(kr + 64); k2[q4] = *(const u32x4*)(a + (size_t)tok * DOWNP + 384 + 8 * s);
            rc[q4][0] = *(const f32x4*)(rope + (size_t)tok * 64 + 8 * (s & 3)); rc[q4][1] = *(const f32x4*)(rope + (size_t)tok * 64 + 8 * (s & 3) + 4);
            rsn[q4][0] = *(const f32x4*)(rope + (size_t)tok * 64 + 32 + 8 * (s & 3)); rsn[q4][1] = *(const f32x4*)(rope + (size_t)tok * 64 + 32 + 8 * (s & 3) + 4); }
        asm volatile("" ::: "memory");
#pragma unroll
        for (int q4 = 0; q4 < 4; ++q4) { const int it = bt * 4 + q4, tok = pm * 256 + wave * 32 + it * 4 + (slot >> 1), hd = 2 * pn + (slot & 1);
            bf16_t* kr = kb + (size_t)tok * QW + hd * DQK + 8 * s;
            float cs[8], sn[8];
            cs[0] = rc[q4][0].x; cs[1] = rc[q4][0].y; cs[2] = rc[q4][0].z; cs[3] = rc[q4][0].w; cs[4] = rc[q4][1].x; cs[5] = rc[q4][1].y; cs[6] = rc[q4][1].z; cs[7] = rc[q4][1].w;
            sn[0] = rsn[q4][0].x; sn[1] = rsn[q4][0].y; sn[2] = rsn[q4][0].z; sn[3] = rsn[q4][0].w; sn[4] = rsn[q4][1].x; sn[5] = rsn[q4][1].y; sn[6] = rsn[q4][1].z; sn[7] = rsn[q4][1].w;
            qk_head24(k0[q4], k1[q4], k2[q4], gkv, cs, sn, s, 1.0f);
            *(u32x4*)(kr) = k0[q4]; *(u32x4*)(kr + 64) = k1[q4]; *(u32x4*)(kr + 128) = k2[q4]; }
        asm volatile("" ::: "memory");
    }
}
__device__ __forceinline__ void conv_gate(const float* __restrict__ cw  , const bf16_t* __restrict__ bcu, bf16_t* __restrict__ y, int vcu, int G, int tid) {
    constexpr int CHUNK = 16, LD = 2 * DM;
    const int gt = vcu * 512 + tid, NT = G * 512;
    for (int i = gt; i < (MT / CHUNK) * (DM / 8); i += NT) {
        const int c8 = (i & 127) * 8, tok0 = (i >> 7) * CHUNK, t0 = tok0 & (SEQ - 1);
        float w[3][8];
#pragma unroll
        for (int k = 0; k < 3; ++k) { const f32x4 a0 = *(const f32x4*)(cw + k * DM + c8), a1 = *(const f32x4*)(cw + k * DM + c8 + 4);
            w[k][0] = a0.x; w[k][1] = a0.y; w[k][2] = a0.z; w[k][3] = a0.w; w[k][4] = a1.x; w[k][5] = a1.y; w[k][6] = a1.z; w[k][7] = a1.w; }
        float p1[8], p2[8];
#pragma unroll
        for (int e = 0; e < 8; ++e) { p1[e] = 0.f; p2[e] = 0.f; }
        if (t0 > 0) {
            const u32x4 u2 = *(const u32x4*)(bcu + (size_t)(tok0 - 2) * LD + DM + c8), u1 = *(const u32x4*)(bcu + (size_t)(tok0 - 1) * LD + DM + c8);
            p2[0] = bflo(u2.x); p2[1] = bfhi(u2.x); p2[2] = bflo(u2.y); p2[3] = bfhi(u2.y); p2[4] = bflo(u2.z); p2[5] = bfhi(u2.z); p2[6] = bflo(u2.w); p2[7] = bfhi(u2.w);
            p1[0] = bflo(u1.x); p1[1] = bfhi(u1.x); p1[2] = bflo(u1.y); p1[3] = bfhi(u1.y); p1[4] = bflo(u1.z); p1[5] = bfhi(u1.z); p1[6] = bflo(u1.w); p1[7] = bfhi(u1.w);
        }
#pragma unroll 4
        for (int k = 0; k < CHUNK; ++k) {
            const bf16_t* row = bcu + (size_t)(tok0 + k) * LD;
            const u32x4 gb = *(const u32x4*)(row + c8), uc = *(const u32x4*)(row + DM + c8);
            float p0[8], gbf[8];
            p0[0] = bflo(uc.x); p0[1] = bfhi(uc.x); p0[2] = bflo(uc.y); p0[3] = bfhi(uc.y); p0[4] = bflo(uc.z); p0[5] = bfhi(uc.z); p0[6] = bflo(uc.w); p0[7] = bfhi(uc.w);
            gbf[0] = bflo(gb.x); gbf[1] = bfhi(gb.x); gbf[2] = bflo(gb.y); gbf[3] = bfhi(gb.y); gbf[4] = bflo(gb.z); gbf[5] = bfhi(gb.z); gbf[6] = bflo(gb.w); gbf[7] = bfhi(gb.w);
            float o[8];
#pragma unroll
            for (int e = 0; e < 8; ++e) { o[e] = gbf[e] * (w[0][e] * p2[e] + w[1][e] * p1[e] + w[2][e] * p0[e]); p2[e] = p1[e]; p1[e] = p0[e]; }
            u32x4 ov; ov.x = pk2(o[0], o[1]); ov.y = pk2(o[2], o[3]); ov.z = pk2(o[4], o[5]); ov.w = pk2(o[6], o[7]);
            *(u32x4*)(y + (size_t)(tok0 + k) * DM + c8) = ov;
        }
    }
}

#define XB_TMO      128
#define XB_XCNT(j)  (256  + 64 * (j))
#define XB_XSUB(j)  (1280 + 64 * (j))
#define XB_XGEN(j)  (2304 + 64 * (j))
#define XB_TOP      3328
#define XB_TOPGEN   3392
#define XCD_BAR_WORDS 3456
#define XB_SPIN_CAP (1u << 18)
__device__ __forceinline__ unsigned xb_ld(unsigned* p)              { return __hip_atomic_load(p, __ATOMIC_RELAXED, __HIP_MEMORY_SCOPE_AGENT); }
__device__ __forceinline__ unsigned xb_add(unsigned* p, unsigned v) { return __hip_atomic_fetch_add(p, v, __ATOMIC_RELAXED, __HIP_MEMORY_SCOPE_AGENT); }
__device__ __forceinline__ unsigned xb_xcc_id() { return (unsigned)__builtin_amdgcn_s_getreg((3 << 11) | 20) & 0xFu; }
#define XB_SPIN(cond, bar) do { unsigned _sp = 0; while (cond) { __builtin_amdgcn_s_sleep(1); \
    if ((++_sp & 255u) == 0u) { if (xb_ld(&(bar)[XB_TMO])) break; if (_sp > XB_SPIN_CAP) { atomicAdd(&(bar)[XB_TMO], 1u); break; } } } } while (0)
struct XcdBarrier { unsigned* bar; unsigned x; volatile LAS unsigned* st; };
__device__ __forceinline__ XcdBarrier xcd_barrier_post(unsigned* bar, volatile LAS unsigned* st) {
    XcdBarrier b; b.bar = bar; b.x = xb_xcc_id(); b.st = st;
    if (threadIdx.x == 0) (void)xb_add(&bar[XB_XCNT(b.x)], 1u);
    return b;
}
__device__ __forceinline__ void xcd_barrier_complete(unsigned* bar, unsigned x, unsigned& nloc, unsigned& nx) {
    const unsigned G = gridDim.x * gridDim.y * gridDim.z;
    unsigned sum, cnt, mine, sp = 0u;
    for (;;) {
        sum = 0u; cnt = 0u; mine = 0u;
#pragma unroll
        for (unsigned j = 0; j < 16; ++j) { const unsigned c = xb_ld(&bar[XB_XCNT(j)]); sum += c; cnt += (c > 0u) ? 1u : 0u; mine = (j == x) ? c : mine; }
        if (sum == G) break;
        __builtin_amdgcn_s_sleep(1);
        if ((++sp & 255u) == 0u) { if (xb_ld(&bar[XB_TMO])) break; if (sp > XB_SPIN_CAP) { atomicAdd(&bar[XB_TMO], 1u); break; } }
    }
    nloc = mine > 0u ? mine : 1u; nx = cnt > 0u ? cnt : 1u;
}
__device__ __forceinline__ void xcd_barrier(const XcdBarrier& b) {
    asm volatile("s_waitcnt vmcnt(0)" ::: "memory");
    __syncthreads();
    if (threadIdx.x == 0) {
        unsigned* bar = b.bar;
        __builtin_amdgcn_s_waitcnt(0);
        unsigned nloc = b.st[0], nx = b.st[1];
        if (nloc == 0u) { xcd_barrier_complete(bar, b.x, nloc, nx); b.st[0] = nloc; b.st[1] = nx; }
        const unsigned old = xb_add(&bar[XB_XSUB(b.x)], 1u);
        const unsigned gen = old / nloc;
        if (old + 1u == (gen + 1u) * nloc) {
            __builtin_amdgcn_fence(__ATOMIC_RELEASE, "agent");
            asm volatile("s_waitcnt vmcnt(0)" ::: "memory");
            const unsigned og = xb_add(&bar[XB_TOP], 1u);
            const unsigned tg = og / nx;
            if (og + 1u == (tg + 1u) * nx) xb_add(&bar[XB_TOPGEN], 1u);
            else XB_SPIN(xb_ld(&bar[XB_TOPGEN]) == tg, bar);
            __builtin_amdgcn_fence(__ATOMIC_ACQUIRE, "agent");
            xb_add(&bar[XB_XGEN(b.x)], 1u);
            asm volatile("s_waitcnt vmcnt(0)" ::: "memory");
        } else {
            XB_SPIN(xb_ld(&bar[XB_XGEN(b.x)]) == gen, bar);
            __builtin_amdgcn_fence(__ATOMIC_ACQUIRE, "agent");
            asm volatile("s_waitcnt vmcnt(0)" ::: "memory");
        }
    }
    __syncthreads();
}

constexpr int RING_BYTES = 131072, MISC_OFF = RING_BYTES + 320, LDS_BYTES = 147456;
static_assert(att2::L_END <= RING_BYTES && pg8::STAGE_BYTES <= RING_BYTES, "LDS map");
constexpr int PH_PER_LAYER = 7, NPH = 1 + NLAYER * PH_PER_LAYER;
struct Args { In in; float* out; unsigned char* ws; int ph_lo, ph_hi, nogemm, noattn; };

__global__ void __launch_bounds__(512, 2) mk_fwd(Args args) {
    extern __shared__ __attribute__((aligned(16))) unsigned char lds_raw[];
    LAS unsigned char* lds = (LAS unsigned char*)lds_raw;
    const int tid = threadIdx.x, G = gridDim.x, bx = blockIdx.x;
    const int vcu = (G % 8 == 0) ? (bx % 8) * (G / 8) + bx / 8 : bx;
    unsigned char* ws = args.ws; const In& in = args.in;
    const int lo = args.ph_lo, hi = args.ph_hi;
    cg::grid_group grid = cg::this_grid();
    volatile LAS unsigned* MISC = (volatile LAS unsigned*)(lds + MISC_OFF);
    if (tid < 32) MISC[tid] = 0u;
    __syncthreads();
#define GRID_BAR() xcd_barrier(bar)
#define IN(k) (lo <= (k) && (k) < hi)
#define SEAM(k) do { if (IN(k) && IN((k) + 1)) GRID_BAR(); } while (0)

    if (bx == 0) { unsigned* bw = (unsigned*)(ws + WS_CTL) + 1024; for (int i = tid; i < XCD_BAR_WORDS; i += 512) bw[i] = 0u; }
    prologue(in, ws, lds, vcu, G, tid);
    grid.sync();
    XcdBarrier bar = xcd_barrier_post((unsigned*)(ws + WS_CTL) + 1024, MISC + 8);
    bf16_t* cur = (bf16_t*)(ws + WS_XA); bf16_t* alt = (bf16_t*)(ws + WS_XC);
    bf16_t* big = (bf16_t*)(ws + WS_BIG);
    float* ssx = (float*)(ws + WS_SSX); float* ssa = (float*)(ws + WS_SSA);
    bf16_t* w1t = (bf16_t*)(ws + WS_WMLP); bf16_t* w2t = w1t + (size_t)FF * DM;
    for (int L = 0; L < NLAYER; ++L) {
        const int base = 1 + L * PH_PER_LAYER, j = L >> 1; const bool mla = !(L & 1);
        int tl = tid; asm volatile("" : "+v"(tl));
        if (IN(base + 0)) {
            constexpr int NU_DOWN = (MT / 256) * (DOWNP / 256);
            { const bool idle_only = mla && G > NU_DOWN && !args.nogemm;
              const int cgw = (idle_only ? (bx - NU_DOWN) : vcu) * 8 + (tl >> 6), cngw = (idle_only ? (G - NU_DOWN) : G) * 8;
              if (!idle_only || bx >= NU_DOWN) {
                  convert_mlp(in, ws, L, (LAS float*)(lds + (tl >> 6) * 16384), cgw, cngw, tl & 63);
                  if (mla) convert_conv(in, ws, j, (LAS float*)(lds + (tl >> 6) * 16384), cgw, cngw, tl & 63);
              } }
            __syncthreads();
            if (!args.nogemm) {
                if (mla) {
                    pg8::Gemm g{cur, mla_w(ws, j).wd, MT, DOWNP, DM, DM, DM}; pg8::StaticOrder S; S.init(MT, DOWNP, G, bx);
                    int tpm = -1; { pg8::Unit u0; if (S.next(0, u0)) { tpm = u0.pm; pg8::fill_rstd_tab((LAS float*)(lds + RING_BYTES + 1024), ssx, 16, 4, 1.0f / DM, tpm, tl); } } __syncthreads();
                    pg8::EpiScale<0, 0, 1> E{alt, DOWNP, ssx, 16, 4, 1.0f / DM, ssa, (LAS float*)(lds + RING_BYTES + 1024), tpm};
                    if (DBG_ON(0)) pg8::gemm_phase<pg8::EpiScale<0, 0, 1>, pg8::StaticOrder, true>(lds, g, S, E);
                } else {
                    pg8::Gemm g{cur, conv_w(ws, j).win, MT, 3 * DM, DM, DM, DM}; pg8::StaticOrder S; S.init(MT, 3 * DM, G, bx);
                    int tpm = -1; { pg8::Unit u0; if (S.next(0, u0)) { tpm = u0.pm; pg8::fill_rstd_tab((LAS float*)(lds + RING_BYTES + 1024), ssx, 16, 4, 1.0f / DM, tpm, tl); } } __syncthreads();
                    pg8::EpiConvIn E{big, ssx, (LAS float*)(lds + RING_BYTES + 1024), tpm};
                    if (DBG_ON(1)) pg8::gemm_phase<pg8::EpiConvIn, pg8::StaticOrder, true>(lds, g, S, E);
                }
            }
        }
        if (mla) {
            bf16_t* qb = big; bf16_t* kb = big + (size_t)MT * QW; bf16_t* vt = kb + (size_t)MT * QW;
            SEAM(base + 0);
            if (IN(base + 1) && !args.nogemm) {
                const MlaW w = mla_w(ws, j);
                { pg8::Gemm g{alt, w.wuq, MT, QW, QLORA, DOWNP, QLORA}; pg8::StaticOrder S; S.init(MT, QW, G, bx);
                  pg8::EpiScale<0, 0, 0> E{qb, QW, ssa, 8, 1, 1.0f / QLORA, nullptr, nullptr, -1};
                  if (DBG_ON(2)) pg8::gemm_phase<pg8::EpiScale<0, 0, 0>, pg8::StaticOrder, true>(lds, g, S, E); }
                { pg8::Gemm g{alt + QLORA, w.wuk, MT, 1024, KVLORA, DOWNP, KVLORA}; pg8::StaticOrder S; S.init(MT, 1024, G, bx);
                  pg8::EpiScale<0, 1, 0> E{kb, QW, ssa + 4, 8, 1, 1.0f / KVLORA, nullptr, nullptr, -1};
                  if (DBG_ON(3)) pg8::gemm_phase<pg8::EpiScale<0, 1, 0>, pg8::StaticOrder, true>(lds, g, S, E);
                  if ((tl >> 6) == 0) __builtin_amdgcn_fence(__ATOMIC_ACQUIRE, "agent");
                  asm volatile("s_waitcnt vmcnt(0)" ::: "memory"); __syncthreads();
                  pg8::Unit u; for (int i = 0; S.next(i, u); ++i) knorm_unit(in.g_kn + j * DQK, in.g_qn + j * DQK, (const float*)(ws + WS_ROPE), kb, alt, u.pm, u.pn, tl); }
                { pg8::Gemm g{w.wuvt, alt + QLORA, 1024, MT, KVLORA, KVLORA, DOWNP}; pg8::StaticOrder S; S.init(1024, MT, G, bx);
                  pg8::EpiVT E{vt, MT, ssa};
                  if (DBG_ON(4)) pg8::gemm_phase<pg8::EpiVT, pg8::StaticOrder, true>(lds, g, S, E); }
            }
            SEAM(base + 1);
                        if (IN(base + 3) && !args.noattn) ATT_NS::attn_phase(lds, vcu, G, qb, kb, vt, alt, in.g_qn + j * DQK, (const float*)(ws + WS_ROPE));
            SEAM(base + 3);
            if (IN(base + 4) && !args.nogemm) {
                pg8::Gemm g{alt, mla_w(ws, j).wo, MT, DM, DM, DM, DM}; pg8::StaticOrder S; S.init(MT, DM, G, bx);
                pg8::EpiResid<false> E{cur, nullptr, ssx};
                if (DBG_ON(5)) pg8::gemm_phase<pg8::EpiResid<false>, pg8::StaticOrder, true>(lds, g, S, E);
            }
            SEAM(base + 4);
        } else {
            SEAM(base + 0);
            if (IN(base + 2)) conv_gate(in.c_w + (size_t)j * 3 * DM, big, alt, vcu, G, tl);
            if (IN(base + 2) && IN(base + 4)) GRID_BAR();
            if (IN(base + 4) && !args.nogemm) {
                pg8::Gemm g{alt, conv_w(ws, j).wout, MT, DM, DM, DM, DM}; pg8::StaticOrder S; S.init(MT, DM, G, bx);
                pg8::EpiResid<false> E{cur, nullptr, ssx};
                if (DBG_ON(6)) pg8::gemm_phase<pg8::EpiResid<false>, pg8::StaticOrder, true>(lds, g, S, E);
            }
            SEAM(base + 4);
        }
        if (IN(base + 5) && !args.nogemm) {
            pg8::Gemm g{cur, w1t, MT, FF, DM, DM, DM}; pg8::StaticOrder S; S.init(MT, FF, G, bx);
            int tpm = -1; { pg8::Unit u0; if (S.next(0, u0)) { tpm = u0.pm; pg8::fill_rstd_tab((LAS float*)(lds + RING_BYTES + 1024), ssx, 16, 4, 1.0f / DM, tpm, tl); } } __syncthreads();
            pg8::EpiScale<1, 0, 0> E{big, FF, ssx, 16, 4, 1.0f / DM, nullptr, (LAS float*)(lds + RING_BYTES + 1024), tpm};
            if (DBG_ON(7)) pg8::gemm_phase<pg8::EpiScale<1, 0, 0>, pg8::StaticOrder, true>(lds, g, S, E);
        }
        SEAM(base + 5);
        if (IN(base + 6) && !args.nogemm) {
            pg8::Gemm g{big, w2t, MT, DM, FF, FF, FF}; pg8::StaticOrder S; S.init(MT, DM, G, bx);
            if (L + 1 < NLAYER) { pg8::EpiResid<false> E{cur, nullptr, ssx};
                if (DBG_ON(8)) pg8::gemm_phase<pg8::EpiResid<false>, pg8::StaticOrder, true>(lds, g, S, E); }
            else { pg8::EpiResid<true> E{cur, args.out, ssx};
                if (DBG_ON(8)) pg8::gemm_phase<pg8::EpiResid<true>, pg8::StaticOrder, true>(lds, g, S, E); }
        }
        if (L + 1 < NLAYER) SEAM(base + 6);
    }
#undef IN
#undef SEAM
}

extern "C" void kernel_launch(void* const* d_in, const int* in_sizes, int n_in, void* d_out, int out_size, void* d_ws, size_t ws_size, hipStream_t stream) {
    static int grid = 0;
    if (grid == 0) {
        if (n_in != 17 || out_size != MT * DM || ws_size < WS_END) { fprintf(stderr, "kernel_launch: unexpected problem shape (n_in %d, out %d, ws %zu)\n", n_in, out_size, ws_size); grid = -1; return; }
        int dev = 0, cus = 0, per_cu = 0;
        hipGetDevice(&dev); hipDeviceGetAttribute(&cus, hipDeviceAttributeMultiprocessorCount, dev);
        if (hipFuncSetAttribute((const void*)mk_fwd, hipFuncAttributeMaxDynamicSharedMemorySize, LDS_BYTES) != hipSuccess) { fprintf(stderr, "kernel_launch: hipFuncSetAttribute failed\n"); grid = -1; return; }
        if (hipOccupancyMaxActiveBlocksPerMultiprocessor(&per_cu, (const void*)mk_fwd, 512, LDS_BYTES) != hipSuccess || per_cu < 1) { fprintf(stderr, "kernel_launch: occupancy query says %d\n", per_cu); per_cu = 1; }
        (void)hipGetLastError();
        grid = cus * per_cu;
    }
    if (grid < 0) return;
    Args a{};
    const void** ip = (const void**)&a.in;
    for (int i = 0; i < 17; ++i) ip[i] = d_in[i];
    a.out = (float*)d_out; a.ws = (unsigned char*)d_ws; a.nogemm = 0; a.noattn = 0;
    a.ph_lo = 0; a.ph_hi = NPH;
    void* kargs[] = {&a};
    hipError_t e = hipLaunchCooperativeKernel((const void*)mk_fwd, dim3(grid), dim3(512), kargs, LDS_BYTES, stream);
    if (e != hipSuccess) fprintf(stderr, "kernel_launch: cooperative launch failed: %s (grid %d)\n", hipGetErrorString(e), grid);
}
```
